# Optimizing an MI355X kernel written in HIP

```python
import math
import jax, jax.numpy as jnp
from jax import lax
import numpy as np

D_MODEL = 1024
BATCH = 8
SEQ = 2048
DEPTH = 1
DEC_BATCH = 128
DEC_SEQ = 8
PAST_LEN = 16384
PAGE_SIZE = 128

POOL_WINDOWS = (2, 4, 8, 16)
N_POOL_GROUPS = 4
D_POOL = D_MODEL
POOL_GROUP = D_POOL // N_POOL_GROUPS
POOL_BUF = 15
N_HEADS = 8
HEAD_K = D_MODEL // N_HEADS
HEAD_V = D_MODEL // N_HEADS
D_QK = N_HEADS * HEAD_K
D_V = N_HEADS * HEAD_V
D_CONV_CH = 2 * D_QK + D_V
CONV_W = 4
CHUNK = 64
N_BRANCH = 2
D_IN = 2 * D_POOL + 2 * D_QK + 2 * D_V + 2 * N_HEADS + N_BRANCH * D_MODEL
DEEPNORM_ALPHA = (2 * DEPTH) ** 0.25
DEEPNORM_BETA = (8 * DEPTH) ** -0.25
LN_EPS = 1e-5
RMS_EPS = 1e-6
L2_EPS = 1e-6

kernel_name = 'pool_gdn_gated_hybrid_step'


def _in_offsets():
    sizes = (D_POOL, D_POOL, D_QK, D_QK, D_V, D_V, N_HEADS, N_HEADS, D_MODEL, D_MODEL)
    return [int(s) for s in np.cumsum(sizes)[:-1]]


def _pool_mixer(u, buf, pos0, pool_w, pool_scale):
    bsz, t_len, _ = u.shape
    ext = jnp.concatenate([buf.astype(u.dtype), u], axis=1)
    ext32 = ext.astype(jnp.float32)
    cs = jnp.concatenate([jnp.zeros_like(ext32[:, :1]), jnp.cumsum(ext32, axis=1)], axis=1)
    pos = pos0 + jnp.arange(t_len, dtype=jnp.int32)
    means = []
    for gi, w in enumerate(POOL_WINDOWS):
        ch = slice(gi * POOL_GROUP, (gi + 1) * POOL_GROUP)
        hi = cs[:, POOL_BUF + 1:POOL_BUF + 1 + t_len, ch]
        lo = cs[:, POOL_BUF + 1 - w:POOL_BUF + 1 - w + t_len, ch]
        cnt = jnp.minimum(pos + 1, w).astype(jnp.float32)[None, :, None]
        means.append((hi - lo) / cnt)
    pooled = (jnp.concatenate(means, axis=-1) - ext32[:, POOL_BUF:]).astype(u.dtype)
    pooled = pooled.reshape(bsz, t_len, N_POOL_GROUPS, POOL_GROUP)
    mixed = jnp.einsum('btgc,gcd->btgd', pooled, pool_w).reshape(bsz, t_len, D_POOL) * pool_scale
    return mixed, ext[:, -POOL_BUF:]


def _short_conv(xc, buf, conv_w):
    t_len = xc.shape[1]
    ext = jnp.concatenate([buf.astype(xc.dtype), xc], axis=1)
    out = sum(ext[:, i:i + t_len] * conv_w[i] for i in range(CONV_W))
    return jax.nn.silu(out), ext[:, -(CONV_W - 1):]


def _l2norm(a):
    return a * lax.rsqrt(jnp.sum(a * a, axis=-1, keepdims=True) + L2_EPS)


def _chunk_gated_delta(q, k, v, beta, g, s0):
    bsz, t_len, n_h, _ = q.shape
    c = min(CHUNK, t_len)
    n_c = -(-t_len // c)
    pad = n_c * c - t_len

    def prep(a):
        a = jnp.pad(a, [(0, 0), (0, pad)] + [(0, 0)] * (a.ndim - 2))
        a = a.reshape((bsz, n_c, c) + a.shape[2:])
        return jnp.moveaxis(jnp.moveaxis(a, 3, 2), 1, 0)

    q, k, v, beta, g = prep(q), prep(k), prep(v), prep(beta), prep(g)
    gc = jnp.cumsum(g, axis=-1)
    incl = jnp.tril(jnp.ones((c, c), dtype=bool))
    strict = jnp.tril(jnp.ones((c, c), dtype=bool), -1)
    decay = jnp.exp(jnp.where(incl, gc[..., :, None] - gc[..., None, :], -jnp.inf))
    kk = jnp.einsum('nbhrd,nbhjd->nbhrj', k, k)
    lmat = jnp.where(strict, beta[..., :, None] * decay * kk, 0.0) + jnp.eye(c, dtype=jnp.float32)
    gam = jnp.exp(gc)
    rhs = jnp.concatenate([beta[..., None] * v, (beta * gam)[..., None] * k], axis=-1)
    sol = lax.linalg.triangular_solve(lmat, rhs, left_side=True, lower=True, unit_diagonal=True)
    w_v, w_k = sol[..., :HEAD_V], sol[..., HEAD_V:]
    qk = jnp.einsum('nbhrd,nbhjd->nbhrj', q, k) * decay
    qg = q * gam[..., None]
    kt = k * jnp.exp(gc[..., -1:] - gc)[..., None]
    glast = gam[..., -1]

    def step(s, xs):
        wv_c, wk_c, qk_c, qg_c, kt_c, gl_c = xs
        u = wv_c - jnp.einsum('bhcd,bhde->bhce', wk_c, s)
        o = jnp.einsum('bhcd,bhde->bhce', qg_c, s) + jnp.einsum('bhrj,bhje->bhre', qk_c, u)
        s = gl_c[..., None, None] * s + jnp.einsum('bhcd,bhce->bhde', kt_c, u)
        return s, o

    s_fin, o = lax.scan(step, s0, (w_v, w_k, qk, qg, kt, glast))
    o = jnp.transpose(o, (1, 0, 3, 2, 4)).reshape(bsz, n_c * c, n_h, HEAD_V)[:, :t_len]
    return o, s_fin


def _layer(x, c, pool_buf, conv_buf, s0, pos0, w_ada, b_ada, w_in, conv_w, a_log, dt_bias,
           head_norm_w, pool_w, pool_scale, p_a, p_b, w_out, ln_g, ln_b):
    dt = x.dtype
    bsz, t_len, _ = x.shape
    mod = jax.nn.silu(c) @ w_ada + b_ada
    shift, scale, gate = jnp.split(mod[:, None, :], 3, axis=-1)
    h = x * (1 + scale) + shift
    proj = h @ w_in
    u_a, z_a, q, k, v, z_b, b_raw, a_raw, ga_raw, gb_raw = jnp.split(proj, _in_offsets(), axis=-1)
    y_a, new_pool = _pool_mixer(u_a, pool_buf, pos0, pool_w, pool_scale)
    y_a = y_a * jax.nn.silu(z_a)
    qkv, new_conv = _short_conv(jnp.concatenate([q, k, v], axis=-1), conv_buf, conv_w)
    q, k, v = jnp.split(qkv.astype(jnp.float32), [D_QK, 2 * D_QK], axis=-1)
    q = _l2norm(q.reshape(bsz, t_len, N_HEADS, HEAD_K)) * (HEAD_K ** -0.5)
    k = _l2norm(k.reshape(bsz, t_len, N_HEADS, HEAD_K))
    v = v.reshape(bsz, t_len, N_HEADS, HEAD_V)
    beta = jax.nn.sigmoid(b_raw.astype(jnp.float32))
    g = -jnp.exp(a_log.astype(jnp.float32)) * jax.nn.softplus(a_raw.astype(jnp.float32) + dt_bias.astype(jnp.float32))
    o, s_new = _chunk_gated_delta(q, k, v, beta, g, s0.astype(jnp.float32))
    o = o * lax.rsqrt(jnp.mean(o * o, axis=-1, keepdims=True) + RMS_EPS) * head_norm_w.astype(jnp.float32)
    y_b = o.reshape(bsz, t_len, D_V).astype(dt) * jax.nn.silu(z_b)
    merged = jax.nn.sigmoid(ga_raw) * (y_a @ p_a) + jax.nn.sigmoid(gb_raw) * (y_b @ p_b)
    sub = (1 + gate) * (merged @ w_out)
    r = (DEEPNORM_ALPHA * x + sub).astype(jnp.float32)
    mu = jnp.mean(r, axis=-1, keepdims=True)
    var = jnp.mean(jnp.square(r - mu), axis=-1, keepdims=True)
    y = (r - mu) * lax.rsqrt(var + LN_EPS) * ln_g.astype(jnp.float32) + ln_b.astype(jnp.float32)
    return y.astype(dt), new_pool, new_conv, s_new.astype(dt)


def setup_inputs(seed: int = 0) -> dict:
    key = jax.random.key(seed)
    ks = jax.random.split(key, 24)
    f32 = jnp.float32
    nrm = lambda kk, shape, s: jax.random.normal(kk, shape, f32) * s
    dt_init = jnp.exp(jax.random.uniform(ks[10], (DEPTH, N_HEADS), f32, math.log(1e-3), math.log(1e-1)))
    return {
        'x_prompt': nrm(ks[0], (BATCH, SEQ, D_MODEL), 1.0),
        'x_sample': nrm(ks[1], (DEC_BATCH, DEC_SEQ, D_MODEL), 1.0),
        'state_pool': nrm(ks[2], (DEPTH, DEC_BATCH, POOL_BUF, D_POOL), 1.0),
        'state_conv': nrm(ks[3], (DEPTH, DEC_BATCH, CONV_W - 1, D_CONV_CH), 1.0),
        'state_delta': nrm(ks[4], (DEPTH, DEC_BATCH, N_HEADS, HEAD_K, HEAD_V), 0.05),
        'c_prompt': nrm(ks[5], (BATCH, D_MODEL), 1.0),
        'c_sample': nrm(ks[6], (DEC_BATCH, D_MODEL), 1.0),
        'w_ada': nrm(ks[7], (DEPTH, D_MODEL, 3 * D_MODEL), 0.02 * D_MODEL ** -0.5),
        'b_ada': nrm(ks[8], (DEPTH, 3 * D_MODEL), 0.02),
        'w_in': nrm(ks[9], (DEPTH, D_MODEL, D_IN), D_MODEL ** -0.5),
        'conv_w': nrm(ks[11], (DEPTH, CONV_W, D_CONV_CH), CONV_W ** -0.5),
        'a_log': jnp.log(jax.random.uniform(ks[12], (DEPTH, N_HEADS), f32, 1.0, 16.0)),
        'dt_bias': dt_init + jnp.log(-jnp.expm1(-dt_init)),
        'head_norm_w': 1.0 + nrm(ks[13], (DEPTH, HEAD_V), 0.02),
        'pool_w': nrm(ks[14], (DEPTH, N_POOL_GROUPS, POOL_GROUP, POOL_GROUP), POOL_GROUP ** -0.5),
        'pool_scale': 1.0 + nrm(ks[15], (DEPTH, D_POOL), 0.02),
        'p_a': nrm(ks[16], (DEPTH, D_POOL, D_MODEL), DEEPNORM_BETA * D_POOL ** -0.5),
        'p_b': nrm(ks[17], (DEPTH, D_V, D_MODEL), DEEPNORM_BETA * D_V ** -0.5),
        'w_out': nrm(ks[18], (DEPTH, D_MODEL, D_MODEL), DEEPNORM_BETA * D_MODEL ** -0.5),
        'ln_g': 1.0 + nrm(ks[19], (DEPTH, D_MODEL), 0.02),
        'ln_b': nrm(ks[20], (DEPTH, D_MODEL), 0.02),
    }


def reference(x_prompt, x_sample, state_pool, state_conv, state_delta, c_prompt, c_sample,
              w_ada, b_ada, w_in, conv_w, a_log, dt_bias, head_norm_w, pool_w, pool_scale,
              p_a, p_b, w_out, ln_g, ln_b):
    bp = x_prompt.shape[0]
    hp, hs = x_prompt, x_sample
    pool_p, conv_p, delta_p, pool_s, conv_s, delta_s = [], [], [], [], [], []
    for l in range(DEPTH):
        wl = (w_ada[l], b_ada[l], w_in[l], conv_w[l], a_log[l], dt_bias[l], head_norm_w[l],
              pool_w[l], pool_scale[l], p_a[l], p_b[l], w_out[l], ln_g[l], ln_b[l])
        zp = jnp.zeros((bp, POOL_BUF, D_POOL), hp.dtype)
        zc = jnp.zeros((bp, CONV_W - 1, D_CONV_CH), hp.dtype)
        zs = jnp.zeros((bp, N_HEADS, HEAD_K, HEAD_V), jnp.float32)
        hp, npl, ncv, nst = _layer(hp, c_prompt, zp, zc, zs, 0, *wl)
        pool_p.append(npl); conv_p.append(ncv); delta_p.append(nst)
        hs, npl, ncv, nst = _layer(hs, c_sample, state_pool[l], state_conv[l], state_delta[l], PAST_LEN, *wl)
        pool_s.append(npl); conv_s.append(ncv); delta_s.append(nst)
    pool_prompt = jnp.stack(pool_p)
    conv_prompt = jnp.stack(conv_p)
    delta_prompt = jnp.stack(delta_p)
    pool_sample = jnp.stack(pool_s)
    conv_sample = jnp.stack(conv_s)
    delta_sample = jnp.stack(delta_s)
    return (hp, hs, pool_prompt, conv_prompt, delta_prompt, pool_sample, conv_sample, delta_sample)
```

```cpp
#include <hip/hip_runtime.h>
#include <hip/hip_cooperative_groups.h>
#include <stdint.h>
#include <cstdio>
namespace cg = cooperative_groups;

#ifndef MEGA
#define MEGA 1
#endif

typedef unsigned short bf16_t;
typedef short bf16x8 __attribute__((ext_vector_type(8)));
typedef short s16x4 __attribute__((ext_vector_type(4)));
typedef float f32x4 __attribute__((ext_vector_type(4)));
typedef float f32x2 __attribute__((ext_vector_type(2)));
typedef unsigned u32x4 __attribute__((ext_vector_type(4)));
typedef __bf16 bf2_t __attribute__((ext_vector_type(2)));
#define DI __device__ __forceinline__
#define MFMA16(a, b, c) __builtin_amdgcn_mfma_f32_16x16x32_bf16((a), (b), (c), 0, 0, 0)

constexpr int TP = 16384, TS = 1024, TT = 17408, DM = 1024, NSEQ = 136;
constexpr int NMT = 136;
constexpr int WIN_ROWS = 8320;
constexpr int ROW_ZA = 4224, ROW_ZB = 5248, ROW_GA = 6272, ROW_GB = 7296;
constexpr size_t GSZ = (size_t)TT * 1024;
constexpr size_t OFF_YP = 0, OFF_YS = 16777216, OFF_POOLP = 17825792, OFF_CONVP = 17948672, OFF_DELTAP = 18022400,
                 OFF_POOLS = 19070976, OFF_CONVS = 21037056, OFF_DELTAS = 22216704;
constexpr int SMEM_BYTES = 73728;
constexpr int LROW = 144, TILE_B = 128 * LROW;

struct Params {
  const float *xP, *xS, *stPool, *stConv, *stDelta, *cP, *cS, *wAda, *bAda, *wIn, *convW, *aLog, *dtBias, *hnw,
      *poolW, *poolScale, *pA, *pB, *wOut, *lnG, *lnB;
  float* out;
  bf16_t *WinT, *PwT, *PaT, *PbT, *WoT;
  float* mod;
  unsigned* ctr;
  unsigned* bar;
  float *praw, *betaA, *gA, *glastA;
  bf16_t *hbuf, *S0, *S1, *S2, *S3, *VB, *Y0, *Y1, *DS, *KS;
};

DI unsigned pk2(float a, float b) { f32x2 v = {a, b}; bf2_t r = __builtin_convertvector(v, bf2_t); return __builtin_bit_cast(unsigned, r); }
DI bf16_t f2bf(float a) { return (bf16_t)(pk2(a, 0.f) & 0xffffu); }
DI float bflo(unsigned u) { return __uint_as_float(u << 16); }
DI float bfhi(unsigned u) { return __uint_as_float(u & 0xffff0000u); }
DI float bf2f(bf16_t h) { return __uint_as_float((unsigned)h << 16); }
DI float sigmoidf_(float x) { return 1.f / (1.f + __expf(-x)); }
DI float siluf_(float x) { return x / (1.f + __expf(-x)); }
DI int seq_of(int t) { return t < TP ? (t >> 11) : 8 + ((t - TP) >> 3); }

DI void tile_map(int i, int num_n, int& mt, int& nt, int per_xcd = 17) {
  const int xcd = i & 7, seq = i >> 3, per = 8 * num_n;
  const int group = seq / per, first = group * 8, gsz = min(per_xcd - first, 8), rem = seq - group * per;
  mt = (first + rem % gsz) * 8 + xcd; nt = rem / gsz;
}


#define XB_TMO      128
#define XB_XCNT(j)  (256  + 64 * (j))
#define XB_XSUB(j)  (1280 + 64 * (j))
#define XB_XGEN(j)  (2304 + 64 * (j))
#define XB_TOP      3328
#define XB_TOPGEN   3392
#define XCD_BAR_WORDS 3456
#define XB_SPIN_CAP (1u << 18)
#define LAS __attribute__((address_space(3)))
DI unsigned xb_ld(unsigned* p) { return __hip_atomic_load(p, __ATOMIC_RELAXED, __HIP_MEMORY_SCOPE_AGENT); }
DI unsigned xb_add(unsigned* p, unsigned v) { return __hip_atomic_fetch_add(p, v, __ATOMIC_RELAXED, __HIP_MEMORY_SCOPE_AGENT); }
DI unsigned xb_xcc_id() { return (unsigned)__builtin_amdgcn_s_getreg((3 << 11) | 20) & 0xFu; }
#define XB_SPIN(cond, bar) do { unsigned _sp = 0; while (cond) { __builtin_amdgcn_s_sleep(1); \
    if ((++_sp & 255u) == 0u) { if (xb_ld(&(bar)[XB_TMO])) break; if (_sp > XB_SPIN_CAP) { atomicAdd(&(bar)[XB_TMO], 1u); break; } } } } while (0)
struct XcdBarrier { unsigned* bar; unsigned x; volatile LAS unsigned* st; };
DI XcdBarrier xcd_barrier_post(unsigned* bar, volatile LAS unsigned* st) {
  XcdBarrier b; b.bar = bar; b.x = xb_xcc_id(); b.st = st;
  if (threadIdx.x == 0) (void)xb_add(&bar[XB_XCNT(b.x)], 1u);
  return b;
}
DI void xcd_barrier_complete(unsigned* bar, unsigned x, unsigned& nloc, unsigned& nx) {
  const unsigned G = gridDim.x * gridDim.y * gridDim.z;
  unsigned sum, cnt, mine, sp = 0u;
  for (;;) {
    sum = 0u; cnt = 0u; mine = 0u;
#pragma unroll
    for (unsigned j = 0; j < 16; ++j) { const unsigned c = xb_ld(&bar[XB_XCNT(j)]); sum += c; cnt += (c > 0u) ? 1u : 0u; mine = (j == x) ? c : mine; }
    if (sum == G) break;
    __builtin_amdgcn_s_sleep(1);
    if ((++sp & 255u) == 0u) { if (xb_ld(&bar[XB_TMO])) break; if (sp > XB_SPIN_CAP) { atomicAdd(&bar[XB_TMO], 1u); break; } }
  }
  nloc = mine > 0u ? mine : 1u; nx = cnt > 0u ? cnt : 1u;
}
DI void xcd_barrier(const XcdBarrier& b) {
  asm volatile("s_waitcnt vmcnt(0)" ::: "memory");
  __syncthreads();
  if (threadIdx.x == 0) {
    unsigned* bar = b.bar;
    __builtin_amdgcn_s_waitcnt(0);
    unsigned nloc = b.st[0], nx = b.st[1];
    if (nloc == 0u) { xcd_barrier_complete(bar, b.x, nloc, nx); b.st[0] = nloc; b.st[1] = nx; }
    const unsigned old = xb_add(&bar[XB_XSUB(b.x)], 1u);
    const unsigned gen = old / nloc;
    if (old + 1u == (gen + 1u) * nloc) {
      __builtin_amdgcn_fence(__ATOMIC_RELEASE, "agent");
      asm volatile("s_waitcnt vmcnt(0)" ::: "memory");
      const unsigned og = xb_add(&bar[XB_TOP], 1u);
      const unsigned tg = og / nx;
      if (og + 1u == (tg + 1u) * nx) xb_add(&bar[XB_TOPGEN], 1u);
      else XB_SPIN(xb_ld(&bar[XB_TOPGEN]) == tg, bar);
      __builtin_amdgcn_fence(__ATOMIC_ACQUIRE, "agent");
      xb_add(&bar[XB_XGEN(b.x)], 1u);
      asm volatile("s_waitcnt vmcnt(0)" ::: "memory");
    } else {
      XB_SPIN(xb_ld(&bar[XB_XGEN(b.x)]) == gen, bar);
      __builtin_amdgcn_fence(__ATOMIC_ACQUIRE, "agent");
      asm volatile("s_waitcnt vmcnt(0)" ::: "memory");
    }
  }
  __syncthreads();
}

constexpr int NT1K = 768;
DI bool tile_1k(int it, int& m0, int& n0) {
  if (it < 512) { m0 = (it >> 2) * 128; n0 = (it & 3) * 256; return true; }
  const int s = it - 512; m0 = TP + (s >> 3) * 32; n0 = (s & 7) * 128; return false;
}

template <int MI, int NJ> DI void gemm_acc_std(f32x4 (&acc)[MI][NJ], const bf16_t* __restrict__ A, int lda, const bf16_t* __restrict__ Bt, int ldb, int K, char* smem) {
  int tid = threadIdx.x; asm volatile("" : "+v"(tid));
  constexpr int NA = MI == 4 ? 4 : 1;
  const int lane = tid & 63, wave = tid >> 6, wm = MI == 4 ? (wave >> 1) : 0, wn = MI == 4 ? (wave & 1) : wave;
  const int lr = tid >> 3, lc = (tid & 7) * 8;
  u32x4 ra0[4], rb0[4], ra1[4], rb1[4];
  unsigned aofs[4], bofs[4];
#pragma unroll
  for (int i = 0; i < 4; ++i) { aofs[i] = (unsigned)(((lr + 32 * i) * lda + lc) * 2); bofs[i] = (unsigned)(((lr + 32 * i) * ldb + lc) * 2); }
  const __amdgpu_buffer_rsrc_t rsA = __builtin_amdgcn_make_buffer_rsrc((void*)A, 0, 0x7fffffff, 0x00020000);
  const __amdgpu_buffer_rsrc_t rsB = __builtin_amdgcn_make_buffer_rsrc((void*)Bt, 0, 0x7fffffff, 0x00020000);
  const int aoff = (wm * 64 + (lane & 15)) * LROW + (lane >> 4) * 16;
  const int boff = TILE_B + (wn * 16 * NJ + (lane & 15)) * LROW + (lane >> 4) * 16;
  char* const st0 = smem + lr * LROW + lc * 2;
#define GLOAD(RA, RB, k0)                                                                                   \
  _Pragma("unroll") for (int i = 0; i < 4; ++i) {                                                          \
    if (i < NA) RA[i] = __builtin_amdgcn_raw_buffer_load_b128(rsA, aofs[i], (k0) * 2, 0);                   \
    RB[i] = __builtin_amdgcn_raw_buffer_load_b128(rsB, bofs[i], (k0) * 2, 0); }
#define LSTORE(RA, RB, buf)                                                                                 \
  _Pragma("unroll") for (int i = 0; i < 4; ++i) {                                                          \
    if (i < NA) *(u32x4*)(st0 + (buf) * 2 * TILE_B + 32 * i * LROW) = RA[i];                                \
    *(u32x4*)(st0 + (buf) * 2 * TILE_B + TILE_B + 32 * i * LROW) = RB[i]; }
#define COMPUTE(buf)                                                                                        \
  {                                                                                                         \
    const char* sbase = smem + (buf) * 2 * TILE_B;                                                          \
    _Pragma("unroll") for (int ks = 0; ks < 2; ++ks) {                                                      \
      bf16x8 af[MI], bfr[NJ];                                                                               \
      _Pragma("unroll") for (int i = 0; i < MI; ++i) af[i] = *(const bf16x8*)(sbase + aoff + i * 16 * LROW + ks * 64);   \
      _Pragma("unroll") for (int j = 0; j < NJ; ++j) bfr[j] = *(const bf16x8*)(sbase + boff + j * 16 * LROW + ks * 64);  \
      _Pragma("unroll") for (int i = 0; i < MI; ++i)                                                        \
        _Pragma("unroll") for (int j = 0; j < NJ; ++j) acc[i][j] = MFMA16(bfr[j], af[i], acc[i][j]);        \
      if (ks == 0) __builtin_amdgcn_sched_barrier(0);                                                       \
    }                                                                                                       \
  }
  GLOAD(ra0, rb0, 0)
  GLOAD(ra1, rb1, 64)
  LSTORE(ra0, rb0, 0)
  __syncthreads();
  const int nk = K >> 6;
#pragma unroll 1
  for (int kt = 0; kt < nk; kt += 2) {
    if (kt + 2 < nk) { GLOAD(ra0, rb0, (kt + 2) * 64) }
    __builtin_amdgcn_sched_barrier(0);
    COMPUTE(0)
    __builtin_amdgcn_sched_barrier(0);
    LSTORE(ra1, rb1, 1)
    __syncthreads();
    if (kt + 3 < nk) { GLOAD(ra1, rb1, (kt + 3) * 64) }
    __builtin_amdgcn_sched_barrier(0);
    COMPUTE(1)
    __builtin_amdgcn_sched_barrier(0);
    if (kt + 2 < nk) { LSTORE(ra0, rb0, 0) }
    __syncthreads();
  }
#undef GLOAD
#undef LSTORE
#undef COMPUTE
}

DI void gemm_wide(f32x4 (&acc)[4][8], const bf16_t* __restrict__ A, int lda, const bf16_t* __restrict__ Bt, int ldb, int K, char* smem) {
  int tid = threadIdx.x; asm volatile("" : "+v"(tid));
  const int lane = tid & 63, wave = tid >> 6, wm = wave >> 1, wn = wave & 1;
  const int lr = tid >> 3, lc = (tid & 7) * 8;
  u32x4 ra[4], rb[8];
  unsigned aofs[4], bofs[8];
#pragma unroll
  for (int i = 0; i < 4; ++i) aofs[i] = (unsigned)(((lr + 32 * i) * lda + lc) * 2);
#pragma unroll
  for (int i = 0; i < 8; ++i) bofs[i] = (unsigned)(((lr + 32 * i) * ldb + lc) * 2);
  const __amdgpu_buffer_rsrc_t rsA = __builtin_amdgcn_make_buffer_rsrc((void*)A, 0, 0x7fffffff, 0x00020000);
  const __amdgpu_buffer_rsrc_t rsB = __builtin_amdgcn_make_buffer_rsrc((void*)Bt, 0, 0x7fffffff, 0x00020000);
  const int aoff = (wm * 64 + (lane & 15)) * LROW + (lane >> 4) * 16;
  const int boff = TILE_B + (wn * 128 + (lane & 15)) * LROW + (lane >> 4) * 16;
  char* const st0 = smem + lr * LROW + lc * 2;
#define WLOAD(k0)                                                                                          \
  _Pragma("unroll") for (int i = 0; i < 4; ++i) ra[i] = __builtin_amdgcn_raw_buffer_load_b128(rsA, aofs[i], (k0) * 2, 0);  \
  _Pragma("unroll") for (int i = 0; i < 8; ++i) rb[i] = __builtin_amdgcn_raw_buffer_load_b128(rsB, bofs[i], (k0) * 2, 0);
#define WSTORE()                                                                                           \
  _Pragma("unroll") for (int i = 0; i < 4; ++i) *(u32x4*)(st0 + 32 * i * LROW) = ra[i];                     \
  _Pragma("unroll") for (int i = 0; i < 8; ++i) *(u32x4*)(st0 + TILE_B + 32 * i * LROW) = rb[i];
  WLOAD(0)
  WSTORE()
  __syncthreads();
  const int nk = K >> 6;
#pragma unroll 1
  for (int kt = 0; kt < nk; ++kt) {
    if (kt + 1 < nk) { WLOAD((kt + 1) * 64) }
    __builtin_amdgcn_sched_barrier(0);
#pragma unroll
    for (int ks = 0; ks < 2; ++ks) {
      bf16x8 af[4];
#pragma unroll
      for (int i = 0; i < 4; ++i) af[i] = *(const bf16x8*)(smem + aoff + i * 16 * LROW + ks * 64);
#pragma unroll
      for (int jh = 0; jh < 2; ++jh) {
        bf16x8 bfr[4];
#pragma unroll
        for (int j = 0; j < 4; ++j) bfr[j] = *(const bf16x8*)(smem + boff + (jh * 4 + j) * 16 * LROW + ks * 64);
#pragma unroll
        for (int i = 0; i < 4; ++i)
#pragma unroll
          for (int j = 0; j < 4; ++j) acc[i][jh * 4 + j] = MFMA16(bfr[j], af[i], acc[i][jh * 4 + j]);
        __builtin_amdgcn_sched_barrier(0);
      }
    }
    __syncthreads();
    if (kt + 1 < nk) { WSTORE() }
    __syncthreads();
  }
#undef WLOAD
#undef WSTORE
}
template <int MI, int NJ> DI void gemm_acc(f32x4 (&acc)[MI][NJ], const bf16_t* __restrict__ A, int lda, const bf16_t* __restrict__ Bt, int ldb, int K, char* smem) {
  if constexpr (NJ == 8) gemm_wide(acc, A, lda, Bt, ldb, K, smem); else gemm_acc_std<MI, NJ>(acc, A, lda, Bt, ldb, K, smem);
}
template <int MI, int NJ> DI void zero_acc(f32x4 (&acc)[MI][NJ]) {
#pragma unroll
  for (int i = 0; i < MI; ++i)
#pragma unroll
    for (int j = 0; j < NJ; ++j) acc[i][j] = (f32x4){0.f, 0.f, 0.f, 0.f};
}
#define EPI_LOOP(body)                                                                         \
  {                                                                                            \
    int tid_ = threadIdx.x; asm volatile("" : "+v"(tid_));                                    \
    const int lane_ = tid_ & 63, wave_ = tid_ >> 6;                                            \
    const int rb_ = m0 + (MI == 4 ? (wave_ >> 1) * 64 : 0) + (lane_ & 15);                     \
    const int cb_ = n0 + (MI == 4 ? (wave_ & 1) : wave_) * 16 * NJ + (lane_ >> 4) * 4;         \
    _Pragma("unroll") for (int i = 0; i < MI; ++i) _Pragma("unroll") for (int j = 0; j < NJ; ++j) { \
      const int row = rb_ + i * 16;                                                            \
      const int col = cb_ + j * 16;                                                            \
      body                                                                                     \
    }                                                                                          \
  }

#define EPI_ROW(i, body)                                                                       \
  {                                                                                            \
    int tid_ = threadIdx.x; asm volatile("" : "+v"(tid_));                                    \
    const int lane_ = tid_ & 63, wave_ = tid_ >> 6;                                            \
    const int row = m0 + (MI == 4 ? (wave_ >> 1) * 64 : 0) + (lane_ & 15) + (i) * 16;          \
    const int cb_ = n0 + (MI == 4 ? (wave_ & 1) : wave_) * 16 * NJ + (lane_ >> 4) * 4;         \
    _Pragma("unroll") for (int j = 0; j < NJ; ++j) {                                           \
      const int col = cb_ + j * 16;                                                            \
      body                                                                                     \
    }                                                                                          \
  }

DI int queue_next(unsigned* ctr, char* smem) {
  int* sitem = (int*)(smem + SMEM_BYTES);
  if (threadIdx.x == 0) *sitem = (int)atomicAdd(ctr, 1u);
  __syncthreads();
  const int it = *sitem;
  __syncthreads();
  return it;
}

DI void transpose_item(const float* __restrict__ src, int ldS, int col0, int ncols, int k0, bf16_t* __restrict__ dst, int ldD, int row0, char* smem) {
  float* tile = (float*)smem;
  int tid = threadIdx.x; asm volatile("" : "+v"(tid));
  const int tx = tid & 63, ty = tid >> 6;
  float v[32];
#pragma unroll
  for (int i = 0; i < 32; ++i) v[i] = (tx < ncols) ? src[(size_t)(k0 + ty + 4 * i) * ldS + col0 + tx] : 0.f;
#pragma unroll
  for (int i = 0; i < 32; ++i) tile[(ty + 4 * i) * 65 + tx] = v[i];
  __syncthreads();
  const int n = tid >> 2, ksg = (tid & 3) * 32;
  unsigned w[16];
#pragma unroll
  for (int i = 0; i < 16; ++i) w[i] = pk2(tile[(ksg + 2 * i) * 65 + n], tile[(ksg + 2 * i + 1) * 65 + n]);
  uint4* d = (uint4*)(dst + (size_t)(row0 + n) * ldD + k0 + ksg);
  d[0] = make_uint4(w[0], w[1], w[2], w[3]); d[1] = make_uint4(w[4], w[5], w[6], w[7]);
  d[2] = make_uint4(w[8], w[9], w[10], w[11]); d[3] = make_uint4(w[12], w[13], w[14], w[15]);
  __syncthreads();
}
DI void adaln_item(const Params& p, int it, char* smem) {
  const int cgp = it % 48, rg = it / 48, tid = threadIdx.x, lane = tid & 63, wv = tid >> 6;
  float* sc = (float*)smem;
#pragma unroll 1
  for (int kk = 0; kk < 4; ++kk) {
    const int k = tid + 256 * kk;
    float cv[16];
#pragma unroll
    for (int i = 0; i < 16; ++i) {
      const int sq = rg * 16 + i, sc_ = sq < NSEQ ? sq : NSEQ - 1;
      const float* rowp = sc_ < 8 ? p.cP + (size_t)sc_ * 1024 : p.cS + (size_t)(sc_ - 8) * 1024;
      cv[i] = rowp[k];
    }
#pragma unroll
    for (int i = 0; i < 16; ++i) sc[k * 16 + i] = (rg * 16 + i < NSEQ) ? siluf_(cv[i]) : 0.f;
  }
  __syncthreads();
  const int n = cgp * 64 + lane;
  float a[16];
#pragma unroll
  for (int i = 0; i < 16; ++i) a[i] = 0.f;
  const float* wp = p.wAda + (size_t)(wv * 256) * 3072 + n;
  const float* scp = sc + wv * 256 * 16;
#pragma unroll 1
  for (int k0 = 0; k0 < 256; k0 += 32) {
    float w[32];
#pragma unroll
    for (int u = 0; u < 32; ++u) w[u] = wp[(size_t)(k0 + u) * 3072];
#pragma unroll
    for (int u = 0; u < 32; ++u) {
#pragma unroll
      for (int q = 0; q < 4; ++q) {
        const float4 c = *(const float4*)(scp + (k0 + u) * 16 + 4 * q);
        a[4 * q] += w[u] * c.x; a[4 * q + 1] += w[u] * c.y; a[4 * q + 2] += w[u] * c.z; a[4 * q + 3] += w[u] * c.w;
      }
    }
  }
  __syncthreads();
  float* red = sc;
#pragma unroll
  for (int i = 0; i < 16; ++i) red[(wv * 16 + i) * 64 + lane] = a[i];
  __syncthreads();
  for (int o = tid; o < 1024; o += 256) {
    const int i = o >> 6, l = o & 63, nn = cgp * 64 + l, srow = rg * 16 + i;
    const float v = red[(0 * 16 + i) * 64 + l] + red[(1 * 16 + i) * 64 + l] + red[(2 * 16 + i) * 64 + l] + red[(3 * 16 + i) * 64 + l];
    if (srow < NSEQ) p.mod[(size_t)srow * 3072 + nn] = v + p.bAda[nn];
  }
  __syncthreads();
}
DI void phase0(const Params& p, char* smem) {
  const int NA = 432, NIT = NA + 1456;
  while (true) {
    const int it0 = queue_next(p.ctr + 2, smem);
    if (it0 >= NIT) break;
    if (it0 < NA) { adaln_item(p, it0, smem); continue; }
    const int it = it0 - NA;
    if (it < 1024) {
      const int grp = it >> 7, rem = it & 127, nt = rem >> 3, kt = rem & 7;
      const int srcb[8] = {0, 2048, 3072, 4096, 1024, 5120, 6160, 7184};
      const int dstb[8] = {0, 1024, 2048, 3072, ROW_ZA, ROW_ZB, ROW_GA, ROW_GB};
      int sb = 0, db = 0;
#pragma unroll
      for (int g = 0; g < 8; ++g) if (g == grp) { sb = srcb[g]; db = dstb[g]; }
      transpose_item(p.wIn, 8208, sb + nt * 64, 64, kt * 128, p.WinT, 1024, db + nt * 64, smem);
    } else if (it < 1040) {
      const int i2 = it - 1024, nt = i2 >> 3, kt = i2 & 7;
      transpose_item(p.wIn, 8208, 6144 + nt * 64, nt == 0 ? 16 : 0, kt * 128, p.WinT, 1024, 4096 + nt * 64, smem);
    } else if (it < 1072) {
      const int i3 = it - 1040, g = i3 >> 3, rem = i3 & 7, nt = rem >> 1, kt = rem & 1;
      transpose_item(p.poolW + g * 65536, 256, nt * 64, 64, kt * 128, p.PwT + g * 65536, 256, nt * 64, smem);
    } else {
      const int i4 = it - 1072, which = i4 >> 7, rem = i4 & 127, nt = rem >> 3, kt = rem & 7;
      const float* src = which == 0 ? p.pA : (which == 1 ? p.pB : p.wOut);
      bf16_t* dst = which == 0 ? p.PaT : (which == 1 ? p.PbT : p.WoT);
      transpose_item(src, 1024, nt * 64, 64, kt * 128, dst, 1024, nt * 64, smem);
    }
  }
}
DI void phase0b(const Params& p) {
  const int nvec = TT * 128;
  for (int v0 = blockIdx.x * 1024 + threadIdx.x; v0 < nvec; v0 += gridDim.x * 1024) {
    float4 x0[4], x1[4], sh0[4], sh1[4], sc0[4], sc1[4];
#pragma unroll
    for (int u = 0; u < 4; ++u) {
      const int v = v0 + u * 256, t = v >> 7, c = (v & 127) * 8;
      const float* xr = t < TP ? p.xP + (size_t)t * 1024 + c : p.xS + (size_t)(t - TP) * 1024 + c;
      const float* m = p.mod + (size_t)seq_of(t) * 3072 + c;
      x0[u] = *(const float4*)xr; x1[u] = *(const float4*)(xr + 4);
      sh0[u] = *(const float4*)m; sh1[u] = *(const float4*)(m + 4);
      sc0[u] = *(const float4*)(m + 1024); sc1[u] = *(const float4*)(m + 1028);
    }
#pragma unroll
    for (int u = 0; u < 4; ++u) {
      const int v = v0 + u * 256, t = v >> 7, c = (v & 127) * 8;
      uint4 o;
      o.x = pk2(x0[u].x * (1.f + sc0[u].x) + sh0[u].x, x0[u].y * (1.f + sc0[u].y) + sh0[u].y);
      o.y = pk2(x0[u].z * (1.f + sc0[u].z) + sh0[u].z, x0[u].w * (1.f + sc0[u].w) + sh0[u].w);
      o.z = pk2(x1[u].x * (1.f + sc1[u].x) + sh1[u].x, x1[u].y * (1.f + sc1[u].y) + sh1[u].y);
      o.w = pk2(x1[u].z * (1.f + sc1[u].z) + sh1[u].z, x1[u].w * (1.f + sc1[u].w) + sh1[u].w);
      *(uint4*)(p.hbuf + (size_t)t * 1024 + c) = o;
    }
  }
}
template <int MI, int NJ> DI void p1_tile(const Params& p, int m0, int n0, char* smem) {
  f32x4 acc[MI][NJ]; zero_acc(acc);
  gemm_acc<MI, NJ>(acc, p.hbuf + (size_t)m0 * 1024, 1024, p.WinT + (size_t)n0 * 1024, 1024, 1024, smem);
  EPI_LOOP(
    const f32x4 v = acc[i][j];
    if (col < 4096) { uint2 o; o.x = pk2(v[0], v[1]); o.y = pk2(v[2], v[3]); *(uint2*)(p.S0 + (size_t)row * 4096 + col) = o; }
    else if (col < 4112) { *(f32x4*)(p.praw + (size_t)row * 16 + (col - 4096)) = v; }
  )
}
DI void phase1(const Params& p, char* smem) {
  const int NW = NMT * 16, NIT = NW + NMT;
  for (int it = blockIdx.x; it < NIT; it += gridDim.x) {
    if (it < NW) p1_tile<4, 8>(p, (it >> 4) * 128, (it & 15) * 256, smem);
    else p1_tile<4, 4>(p, (it - NW) * 128, 4096, smem);
  }
}
template <int W> DI void pool_compute(const float (&r)[23][4], bool prompt, int p0, float (&po)[8][4]) {
#pragma unroll
  for (int i = 0; i < 8; ++i) {
    const float cnt = prompt ? (float)min(p0 + i + 1, W) : (float)W;
    const float inv = 1.f / cnt;
#pragma unroll
    for (int c = 0; c < 4; ++c) {
      float s = 0.f;
#pragma unroll
      for (int j = 0; j < W; ++j) s += r[15 + i - j][c];
      po[i][c] = s * inv - r[15 + i][c];
    }
  }
}
template <bool PROMPT> DI void p2_item(const Params& p, int gi) {
  const int tid = threadIdx.x, wave = tid >> 6, ch = tid * 4;
  constexpr bool prompt = PROMPT;
  int b = 0, p0 = 0, t0, sb = 0;
  if (prompt) { b = gi >> 8; p0 = (gi & 255) * 8; t0 = b * 2048 + p0; } else { sb = gi - 2048; t0 = TP + sb * 8; }
  const bf16_t* proj = p.S0;
  const bool wstate = (!prompt) || (p0 == 2040);
  {
    float r[23][4];
    {
      uint2 raw[23]; float4 rawf[15];
#pragma unroll
      for (int jj = 0; jj < 23; ++jj) {
        const int j = jj - 15;
        if (prompt) { const int jc = max(j, -p0); raw[jj] = *(const uint2*)(proj + (size_t)(t0 + jc) * 4096 + ch); }
        else if (j >= 0) raw[jj] = *(const uint2*)(proj + (size_t)(t0 + j) * 4096 + ch);
        else rawf[jj] = *(const float4*)(p.stPool + ((size_t)sb * 15 + jj) * 1024 + ch);
      }
#pragma unroll
      for (int jj = 0; jj < 23; ++jj) {
        const int j = jj - 15;
        if (prompt || j >= 0) {
          const float m = (!prompt || p0 + j >= 0) ? 1.f : 0.f;
          r[jj][0] = bflo(raw[jj].x) * m; r[jj][1] = bfhi(raw[jj].x) * m; r[jj][2] = bflo(raw[jj].y) * m; r[jj][3] = bfhi(raw[jj].y) * m;
        } else { r[jj][0] = rawf[jj].x; r[jj][1] = rawf[jj].y; r[jj][2] = rawf[jj].z; r[jj][3] = rawf[jj].w; }
      }
    }
    float po[8][4];
    if (wave == 0) pool_compute<2>(r, prompt, p0, po);
    else if (wave == 1) pool_compute<4>(r, prompt, p0, po);
    else if (wave == 2) pool_compute<8>(r, prompt, p0, po);
    else pool_compute<16>(r, prompt, p0, po);
#pragma unroll
    for (int i = 0; i < 8; ++i) { uint2 o; o.x = pk2(po[i][0], po[i][1]); o.y = pk2(po[i][2], po[i][3]); *(uint2*)(p.DS + (size_t)(t0 + i) * 1024 + ch) = o; }
    if (wstate) {
      float* dst = prompt ? p.out + OFF_POOLP + (size_t)b * 15 * 1024 : p.out + OFF_POOLS + (size_t)sb * 15 * 1024;
#pragma unroll
      for (int jj = 0; jj < 15; ++jj) *(float4*)(dst + jj * 1024 + ch) = make_float4(r[8 + jj][0], r[8 + jj][1], r[8 + jj][2], r[8 + jj][3]);
    }
  }
#pragma unroll
  for (int X = 0; X < 3; ++X) {
    const int cc = X * 1024 + ch;
    float v[11][4];
    {
      uint2 raw[11]; float4 rawf[3];
#pragma unroll
      for (int jj = 0; jj < 11; ++jj) {
        const int j = jj - 3;
        if (prompt) { const int jc = max(j, -p0); raw[jj] = *(const uint2*)(proj + (size_t)(t0 + jc) * 4096 + 1024 + cc); }
        else if (j >= 0) raw[jj] = *(const uint2*)(proj + (size_t)(t0 + j) * 4096 + 1024 + cc);
        else rawf[jj] = *(const float4*)(p.stConv + ((size_t)sb * 3 + jj) * 3072 + cc);
      }
#pragma unroll
      for (int jj = 0; jj < 11; ++jj) {
        const int j = jj - 3;
        if (prompt || j >= 0) {
          const float m = (!prompt || p0 + j >= 0) ? 1.f : 0.f;
          v[jj][0] = bflo(raw[jj].x) * m; v[jj][1] = bfhi(raw[jj].x) * m; v[jj][2] = bflo(raw[jj].y) * m; v[jj][3] = bfhi(raw[jj].y) * m;
        } else { v[jj][0] = rawf[jj].x; v[jj][1] = rawf[jj].y; v[jj][2] = rawf[jj].z; v[jj][3] = rawf[jj].w; }
      }
    }
    if (wstate) {
      float* dst = prompt ? p.out + OFF_CONVP + (size_t)b * 3 * 3072 : p.out + OFF_CONVS + (size_t)sb * 3 * 3072;
#pragma unroll
      for (int jj = 0; jj < 3; ++jj) *(float4*)(dst + jj * 3072 + cc) = make_float4(v[8 + jj][0], v[8 + jj][1], v[8 + jj][2], v[8 + jj][3]);
    }
    float cw[4][4];
#pragma unroll
    for (int m = 0; m < 4; ++m) { const float4 w = *(const float4*)(p.convW + m * 3072 + cc); cw[m][0] = w.x; cw[m][1] = w.y; cw[m][2] = w.z; cw[m][3] = w.w; }
    float o[8][4];
#pragma unroll
    for (int i = 0; i < 8; ++i) {
#pragma unroll
      for (int c = 0; c < 4; ++c) {
        const float s = cw[0][c] * v[i][c] + cw[1][c] * v[i + 1][c] + cw[2][c] * v[i + 2][c] + cw[3][c] * v[i + 3][c];
        o[i][c] = siluf_(s);
      }
      if (X < 2) {
        float ss = o[i][0] * o[i][0] + o[i][1] * o[i][1] + o[i][2] * o[i][2] + o[i][3] * o[i][3];
        ss += __shfl_xor(ss, 1); ss += __shfl_xor(ss, 2); ss += __shfl_xor(ss, 4); ss += __shfl_xor(ss, 8); ss += __shfl_xor(ss, 16);
        const float rn = rsqrtf(ss + 1e-6f) * (X == 0 ? 0.08838834764831845f : 1.f);
#pragma unroll
        for (int c = 0; c < 4; ++c) o[i][c] *= rn;
      }
    }
    if (X == 0) {
      if (prompt) {
        const int hd = tid >> 5, d = (tid & 31) * 4, ks = d >> 5, dd = d & 31, t_ = dd >> 4, kq = (dd & 15) >> 2;
        const int CH = ((b * 32 + (p0 >> 6)) * 8 + hd);
#pragma unroll
        for (int i2 = 0; i2 < 4; ++i2) {
          const int ia = 2 * i2, ib = 2 * i2 + 1;
          unsigned mx = pk2(o[t_ ? ia : ib][0], o[t_ ? ia : ib][1]), my = pk2(o[t_ ? ia : ib][2], o[t_ ? ia : ib][3]);
          const unsigned ox = (unsigned)__shfl_xor((int)mx, 4), oy = (unsigned)__shfl_xor((int)my, 4);
          const int i = t_ ? ib : ia;
          const unsigned kx = pk2(o[i][0], o[i][1]), ky = pk2(o[i][2], o[i][3]);
          uint4 w;
          if (t_ == 0) { w.x = kx; w.y = ky; w.z = ox; w.w = oy; } else { w.x = ox; w.y = oy; w.z = kx; w.w = ky; }
          const int c = (p0 & 63) + i, mt = c >> 4, r_ = c & 15;
          *(uint4*)(p.Y0 + (size_t)CH * 8192 + ((mt * 4 + ks) * 64 + kq * 16 + r_) * 8) = w;
        }
      } else {
#pragma unroll
        for (int i = 0; i < 8; ++i) { uint2 w; w.x = pk2(o[i][0], o[i][1]); w.y = pk2(o[i][2], o[i][3]); *(uint2*)(p.Y0 + (size_t)(t0 + i) * 1024 + ch) = w; }
      }
    } else if (X == 1) {
#pragma unroll
      for (int i = 0; i < 8; ++i) {
        uint2 w; w.x = pk2(o[i][0], o[i][1]); w.y = pk2(o[i][2], o[i][3]);
        bf16_t* kd = prompt ? p.Y1 + (size_t)(t0 + i) * 1024 + ch : p.KS + (size_t)(t0 - TP + i) * 1024 + ch;
        *(uint2*)kd = w;
      }
    } else {
#pragma unroll
      for (int g2 = 0; g2 < 2; ++g2) {
        uint4 w0, w1;
        w0.x = pk2(o[4 * g2][0], o[4 * g2 + 1][0]); w0.y = pk2(o[4 * g2 + 2][0], o[4 * g2 + 3][0]);
        w0.z = pk2(o[4 * g2][1], o[4 * g2 + 1][1]); w0.w = pk2(o[4 * g2 + 2][1], o[4 * g2 + 3][1]);
        w1.x = pk2(o[4 * g2][2], o[4 * g2 + 1][2]); w1.y = pk2(o[4 * g2 + 2][2], o[4 * g2 + 3][2]);
        w1.z = pk2(o[4 * g2][3], o[4 * g2 + 1][3]); w1.w = pk2(o[4 * g2 + 2][3], o[4 * g2 + 3][3]);
        uint4* dst = (uint4*)(p.VB + ((size_t)((t0 >> 2) + g2) * 1024 + ch) * 4);
        dst[0] = w0; dst[1] = w1;
      }
    }
  }
  if (tid < 64) {
    const int i = tid >> 3, hd = tid & 7;
    const float braw = p.praw[(size_t)(t0 + i) * 16 + hd], araw = p.praw[(size_t)(t0 + i) * 16 + 8 + hd];
    const float xx = araw + p.dtBias[hd];
    const float sp = xx > 20.f ? xx : log1pf(__expf(xx));
    p.betaA[(size_t)(t0 + i) * 8 + hd] = sigmoidf_(braw);
    p.gA[(size_t)(t0 + i) * 8 + hd] = -__expf(p.aLog[hd]) * sp;
  }
}
DI void phase2(const Params& p) {
  for (int it = blockIdx.x; it < 2176; it += gridDim.x) { const int gi = (it & 7) * 272 + (it >> 3); if (gi < 2048) p2_item<true>(p, gi); else p2_item<false>(p, gi); }
}
template <int MI, int NJ> DI void p3a_tile(const Params& p, int m0, int n0, char* smem) {
  f32x4 acc[MI][NJ]; zero_acc(acc);
  gemm_acc<MI, NJ>(acc, p.hbuf + (size_t)m0 * 1024, 1024, p.WinT + (size_t)(ROW_ZA + n0) * 1024, 1024, 1024, smem);
  EPI_LOOP(
    const f32x4 ps = *(const f32x4*)(p.poolScale + col);
    const f32x4 v = acc[i][j];
    uint2 o; o.x = pk2(siluf_(v[0]) * ps[0], siluf_(v[1]) * ps[1]); o.y = pk2(siluf_(v[2]) * ps[2], siluf_(v[3]) * ps[3]);
    *(uint2*)(p.S0 + (size_t)row * 1024 + col) = o;
  )
  zero_acc(acc);
  const int grp = n0 >> 8;
  gemm_acc<MI, NJ>(acc, p.DS + (size_t)m0 * 1024 + grp * 256, 1024, p.PwT + (size_t)grp * 65536 + (size_t)(n0 & 255) * 256, 256, 256, smem);
#pragma unroll
  for (int i = 0; i < MI; ++i) {
    uint2 stv[NJ];
    EPI_ROW(i, stv[j] = *(const uint2*)(p.S0 + (size_t)row * 1024 + col); )
    EPI_ROW(i,
      const f32x4 v = acc[i][j];
      const uint2 st = stv[j];
      uint2 o; o.x = pk2(v[0] * bflo(st.x), v[1] * bfhi(st.x)); o.y = pk2(v[2] * bflo(st.y), v[3] * bfhi(st.y));
      *(uint2*)(p.S0 + (size_t)row * 1024 + col) = o;
    )
  }
}
template <bool DRY> DI void p3b_item(const Params& p, int CH, char* smem) {
  int tid = threadIdx.x; asm volatile("" : "+v"(tid));
  const int lane = tid & 63, w = tid >> 6, r = lane & 15, kq = lane >> 4;
  const int hd = CH & 7, cn = CH >> 3, t0 = cn * 64;
  float* gcs = (float*)smem; float* bts = gcs + 64; float* Lm = bts + 64; char* ksm = (char*)(Lm + 4096);
  u32x4 kraw[4], qraw4[4];
  uint2 vraw[16];
  bf16_t* const vbase = p.VB + ((size_t)(t0 >> 2) * 1024 + hd * 128 + (tid & 127)) * 4;
#pragma unroll
  for (int i = 0; i < 4; ++i) {
    const int id = tid + 256 * i, row = id >> 4, c16 = id & 15;
    kraw[i] = *(const u32x4*)(p.Y1 + (size_t)(t0 + row) * 1024 + hd * 128 + c16 * 8);
  }
#pragma unroll
  for (int ks = 0; ks < 4; ++ks) qraw4[ks] = *(const u32x4*)(p.Y0 + (size_t)CH * 8192 + ((w * 4 + ks) * 64 + lane) * 8);
  const int tgb = t0 + (tid & 63);
  const float g_in = p.gA[(size_t)tgb * 8 + hd], b_in = p.betaA[(size_t)tgb * 8 + hd];
  if (tid < 128) {
#pragma unroll
    for (int i = 0; i < 16; ++i) vraw[i] = *(const uint2*)(vbase + (size_t)i * 4096);
  }
#pragma unroll
  for (int i = 0; i < 4; ++i) {
    const int id = tid + 256 * i, row = id >> 4, c16 = id & 15;
    *(u32x4*)(ksm + row * 272 + c16 * 16) = kraw[i];
  }
  if (tid < 64) {
    float g = g_in;
#pragma unroll
    for (int off = 1; off < 64; off <<= 1) { const float v = __shfl_up(g, off); if (lane >= off) g += v; }
    gcs[tid] = g; bts[tid] = b_in;
  }
  __syncthreads();
  const float gl = gcs[63];
  {
    f32x4 akk[4], aqk[4];
#pragma unroll
    for (int nt = 0; nt < 4; ++nt) { akk[nt] = (f32x4){0.f, 0.f, 0.f, 0.f}; aqk[nt] = (f32x4){0.f, 0.f, 0.f, 0.f}; }
    const float gam = __expf(gcs[16 * w + r]);
#pragma unroll
    for (int ks = 0; ks < 4; ++ks) {
      const bf16x8 ka = *(const bf16x8*)(ksm + (16 * w + r) * 272 + ks * 64 + kq * 16);
      bf16_t* qptr = p.Y0 + (size_t)CH * 8192 + ((w * 4 + ks) * 64 + lane) * 8;
      const uint4 qraw = make_uint4(qraw4[ks][0], qraw4[ks][1], qraw4[ks][2], qraw4[ks][3]);
      const bf16x8 qa = __builtin_bit_cast(bf16x8, qraw4[ks]);
#pragma unroll
      for (int nt = 0; nt < 4; ++nt) {
        const bf16x8 kb = *(const bf16x8*)(ksm + (16 * nt + r) * 272 + ks * 64 + kq * 16);
        const s16x4 lo = *(const s16x4*)(ksm + (16 * nt + r) * 272 + (32 * ks + 4 * kq) * 2);
        const s16x4 hi = *(const s16x4*)(ksm + (16 * nt + r) * 272 + (32 * ks + 16 + 4 * kq) * 2);
        const bf16x8 kbp = __builtin_shufflevector(lo, hi, 0, 1, 2, 3, 4, 5, 6, 7);
        akk[nt] = MFMA16(ka, kb, akk[nt]);
        aqk[nt] = MFMA16(qa, kbp, aqk[nt]);
      }
      uint4 qo;
      qo.x = pk2(bflo(qraw.x) * gam, bfhi(qraw.x) * gam); qo.y = pk2(bflo(qraw.y) * gam, bfhi(qraw.y) * gam);
      qo.z = pk2(bflo(qraw.z) * gam, bfhi(qraw.z) * gam); qo.w = pk2(bflo(qraw.w) * gam, bfhi(qraw.w) * gam);
      if (!DRY) *(uint4*)qptr = qo;
    }
#pragma unroll
    for (int nt = 0; nt < 4; ++nt)
#pragma unroll
      for (int j = 0; j < 4; ++j) {
        const int rr = 16 * w + 4 * kq + j, cc = 16 * nt + r;
        const float dec = __expf(fminf(gcs[rr] - gcs[cc], 0.f));
        Lm[rr * 64 + cc] = (cc < rr) ? bts[rr] * dec * akk[nt][j] : 0.f;
        const float qv = (cc <= rr) ? dec * aqk[nt][j] : 0.f;
        const int r3 = rr & 15, ks3 = cc >> 5, dd = cc & 31, t3 = dd >> 4, kq3 = (dd & 15) >> 2, j3 = dd & 3;
        p.S3[(size_t)CH * 4096 + ((w * 2 + ks3) * 64 + kq3 * 16 + r3) * 8 + 4 * t3 + j3] = f2bf(qv);
      }
  }
  __syncthreads();
  {
    float x[64];
    if (tid < 128) {
#pragma unroll
      for (int i = 0; i < 16; ++i) {
        const uint2 u = vraw[i];
        x[4 * i] = bts[4 * i] * bflo(u.x); x[4 * i + 1] = bts[4 * i + 1] * bfhi(u.x);
        x[4 * i + 2] = bts[4 * i + 2] * bflo(u.y); x[4 * i + 3] = bts[4 * i + 3] * bfhi(u.y);
      }
    } else {
      const int d = tid - 128;
#pragma unroll
      for (int rr = 0; rr < 64; ++rr) x[rr] = bts[rr] * __expf(gcs[rr]) * bf2f(*(const bf16_t*)(ksm + rr * 272 + d * 2));
    }
    {
      f32x4 la[12], lb[12], lt[4];
      la[0] = *(const f32x4*)(Lm + 64);
#pragma unroll
      for (int rr = 1; rr < 64; ++rr) {
        if (rr + 1 < 64) {
#pragma unroll
          for (int j4 = 0; j4 < (rr + 4) / 4 && j4 < 12; ++j4) {
            if (rr & 1) lb[j4] = *(const f32x4*)(Lm + (rr + 1) * 64 + 4 * j4); else la[j4] = *(const f32x4*)(Lm + (rr + 1) * 64 + 4 * j4);
          }
        }
#pragma unroll
        for (int j4 = 12; j4 < (rr + 3) / 4; ++j4) lt[j4 - 12] = *(const f32x4*)(Lm + rr * 64 + 4 * j4);
        __builtin_amdgcn_sched_barrier(0);
        float s0 = x[rr], s1 = 0.f;
#pragma unroll
        for (int j4 = 0; j4 < (rr + 3) / 4; ++j4) {
          const f32x4 l = j4 >= 12 ? lt[j4 - 12] : ((rr & 1) ? la[j4] : lb[j4]);
          s0 -= l[0] * x[4 * j4]; s1 -= l[1] * x[4 * j4 + 1]; s0 -= l[2] * x[4 * j4 + 2]; s1 -= l[3] * x[4 * j4 + 3];
        }
        x[rr] = s0 + s1;
        __builtin_amdgcn_sched_barrier(0);
      }
    }
    if (tid < 128) {
#pragma unroll
      for (int i = 0; i < 16; ++i) { uint2 u; u.x = pk2(x[4 * i], x[4 * i + 1]); u.y = pk2(x[4 * i + 2], x[4 * i + 3]); if (!DRY) *(uint2*)(vbase + (size_t)i * 4096) = u; }
    } else {
      const int d = tid - 128, ks_ = d >> 5, dd = d & 31, t_ = dd >> 4, kq_ = (dd & 15) >> 2, j_ = dd & 3;
      bf16_t* wk = p.S1 + (size_t)CH * 8192 + (ks_ * 64 + kq_ * 16) * 8 + 4 * t_ + j_;
#pragma unroll
      for (int rr = 0; rr < 64; ++rr) wk[((rr >> 4) * 4 * 64 + (rr & 15)) * 8] = f2bf(-x[rr]);
    }
  }
#pragma unroll
  for (int i = 0; i < 4; ++i) {
    const int slot = tid + 256 * i, f = slot >> 6, ln = slot & 63, mtp = f >> 1, ksp = f & 1, r2 = ln & 15, kq2 = ln >> 4;
    float vv[8];
#pragma unroll
    for (int t_ = 0; t_ < 2; ++t_)
#pragma unroll
      for (int j = 0; j < 4; ++j) {
        const int c = 32 * ksp + 16 * t_ + 4 * kq2 + j;
        vv[4 * t_ + j] = bf2f(*(const bf16_t*)(ksm + c * 272 + (16 * mtp + r2) * 2)) * __expf(gl - gcs[c]);
      }
    uint4 o; o.x = pk2(vv[0], vv[1]); o.y = pk2(vv[2], vv[3]); o.z = pk2(vv[4], vv[5]); o.w = pk2(vv[6], vv[7]);
    *(uint4*)(p.S2 + (size_t)CH * 8192 + (size_t)slot * 8) = o;
  }
  if (tid == 0) p.glastA[CH] = __expf(gl);
  __syncthreads();
}
template <bool DRY> DI void phase3(const Params& p, char* smem) {
#pragma unroll 1
  for (int pass = 0; pass < 2; ++pass) {
    const bool items = (pass == 0) == (blockIdx.x < 256);
    if (items) {
      while (true) {
        const int it = queue_next(p.ctr + 4, smem);
        if (it >= 2048) break;
        p3b_item<DRY>(p, it, smem);
      }
    } else {
      while (true) {
        const int it = queue_next(p.ctr + 5, smem);
        if (it >= NT1K) break;
        int m0, n0;
        if (tile_1k(it, m0, n0)) p3a_tile<4, 8>(p, m0, n0, smem); else p3a_tile<2, 2>(p, m0, n0, smem);
      }
    }
  }
}
DI bf16x8 pack8(const f32x4& a, const f32x4& b) {
  uint4 u; u.x = pk2(a[0], a[1]); u.y = pk2(a[2], a[3]); u.z = pk2(b[0], b[1]); u.w = pk2(b[2], b[3]);
  return __builtin_bit_cast(bf16x8, u);
}
struct ScanPre { u32x4 wk[4], qg[4], kt[4], qd[2]; uint2 wv[4]; float gl; };
DI void scan_prefetch(const Params& p, ScanPre& r, int chunk  , int hd, int tid, int rq, int ecol) {
  const size_t CH = (size_t)(chunk * 8 + hd);
#pragma unroll
  for (int i = 0; i < 4; ++i) {
    r.wk[i] = ((const u32x4*)(p.S1 + CH * 8192))[tid + 256 * i];
    r.qg[i] = ((const u32x4*)(p.Y0 + CH * 8192))[tid + 256 * i];
    r.kt[i] = ((const u32x4*)(p.S2 + CH * 8192))[tid + 256 * i];
  }
#pragma unroll
  for (int i = 0; i < 2; ++i) r.qd[i] = ((const u32x4*)(p.S3 + CH * 4096))[tid + 256 * i];
  const bf16_t* vb = p.VB + ((size_t)(chunk * 16 + rq) * 1024 + hd * 128 + ecol) * 4;
#pragma unroll
  for (int mt = 0; mt < 4; ++mt) r.wv[mt] = *(const uint2*)(vb + (size_t)(4 * mt) * 4096);
  r.gl = p.glastA[CH];
}
template <bool DRY> DI void scan_step(const Params& p, ScanPre& r, f32x4 (&S)[8], int chunk, bool more, int hd, int tid, int lane, int rq, int ecol, char* smem) {
  __syncthreads();
#pragma unroll
  for (int i = 0; i < 4; ++i) {
    ((u32x4*)smem)[tid + 256 * i] = r.wk[i];
    ((u32x4*)(smem + 16384))[tid + 256 * i] = r.qg[i];
    ((u32x4*)(smem + 32768))[tid + 256 * i] = r.kt[i];
  }
#pragma unroll
  for (int i = 0; i < 2; ++i) ((u32x4*)(smem + 49152))[tid + 256 * i] = r.qd[i];
  f32x4 u[4];
#pragma unroll
  for (int mt = 0; mt < 4; ++mt) u[mt] = (f32x4){bflo(r.wv[mt].x), bfhi(r.wv[mt].x), bflo(r.wv[mt].y), bfhi(r.wv[mt].y)};
  const float gl = r.gl;
  __syncthreads();
  if (more) scan_prefetch(p, r, chunk + 2, hd, tid, rq, ecol);
  bf16x8 Sb[4];
#pragma unroll
  for (int ks = 0; ks < 4; ++ks) Sb[ks] = pack8(S[2 * ks], S[2 * ks + 1]);
  f32x4 o[4];
#pragma unroll
  for (int mt = 0; mt < 4; ++mt) {
    o[mt] = (f32x4){0.f, 0.f, 0.f, 0.f};
#pragma unroll
    for (int ks = 0; ks < 4; ++ks) {
      const bf16x8 a = *(const bf16x8*)(smem + ((mt * 4 + ks) * 64 + lane) * 16);
      u[mt] = MFMA16(a, Sb[ks], u[mt]);
      const bf16x8 q = *(const bf16x8*)(smem + 16384 + ((mt * 4 + ks) * 64 + lane) * 16);
      o[mt] = MFMA16(q, Sb[ks], o[mt]);
    }
  }
  bf16x8 ub[2];
#pragma unroll
  for (int ks = 0; ks < 2; ++ks) ub[ks] = pack8(u[2 * ks], u[2 * ks + 1]);
#pragma unroll
  for (int mt = 0; mt < 4; ++mt)
#pragma unroll
    for (int ks = 0; ks < 2; ++ks) {
      const bf16x8 a = *(const bf16x8*)(smem + 49152 + ((mt * 2 + ks) * 64 + lane) * 16);
      o[mt] = MFMA16(a, ub[ks], o[mt]);
    }
#pragma unroll
  for (int mt = 0; mt < 8; ++mt) {
    S[mt] = S[mt] * gl;
#pragma unroll
    for (int ks = 0; ks < 2; ++ks) {
      const bf16x8 a = *(const bf16x8*)(smem + 32768 + ((mt * 2 + ks) * 64 + lane) * 16);
      S[mt] = MFMA16(a, ub[ks], S[mt]);
    }
  }
  bf16_t* vb = p.VB + ((size_t)(chunk * 16 + rq) * 1024 + hd * 128 + ecol) * 4;
#pragma unroll
  for (int mt = 0; mt < 4; ++mt) { uint2 v; v.x = pk2(o[mt][0], o[mt][1]); v.y = pk2(o[mt][2], o[mt][3]); if (!DRY) *(uint2*)(vb + (size_t)(4 * mt) * 4096) = v; }
}
template <bool DRY> DI void scan_unit(const Params& p, int unit, char* smem) {
  const int tid = threadIdx.x, lane = tid & 63, w = tid >> 6, col = lane & 15, rq = lane >> 4;
  const int bh = unit >> 1, b = bh >> 3, hd = bh & 7, e0 = ((unit & 1) * 4 + w) * 16, ecol = e0 + col;
  f32x4 S[8];
#pragma unroll
  for (int i = 0; i < 8; ++i) S[i] = (f32x4){0.f, 0.f, 0.f, 0.f};
  ScanPre ra, rb;
  scan_prefetch(p, ra, b * 32, hd, tid, rq, ecol);
  scan_prefetch(p, rb, b * 32 + 1, hd, tid, rq, ecol);
#pragma unroll 1
  for (int n = 0; n < 32; n += 2) {
    scan_step<DRY>(p, ra, S, b * 32 + n, n + 2 < 32, hd, tid, lane, rq, ecol, smem);
    scan_step<DRY>(p, rb, S, b * 32 + n + 1, n + 3 < 32, hd, tid, lane, rq, ecol, smem);
  }
  float* dp = p.out + OFF_DELTAP + ((size_t)bh * 128) * 128 + e0 + col;
#pragma unroll
  for (int mt = 0; mt < 8; ++mt)
#pragma unroll
    for (int j = 0; j < 4; ++j) dp[(size_t)(16 * mt + 4 * rq + j) * 128] = S[mt][j];
  __syncthreads();
}
template <bool DRY> DI void sample_item(const Params& p, int item, char* smem) {
  const int tid = threadIdx.x, e = tid >> 1, dh = tid & 1;
  const int sb = item >> 3, hd = item & 7, tb = TP + sb * 8;
  float* qs = (float*)smem; float* ksm = qs + 1024; float* av = ksm + 1024; float* bv = av + 8;
#pragma unroll
  for (int i = 0; i < 4; ++i) {
    const int id = tid + 256 * i, tk = id >> 7, d = id & 127;
    qs[id] = bf2f(p.Y0[(size_t)(tb + tk) * 1024 + hd * 128 + d]);
    ksm[id] = bf2f(p.KS[(size_t)(tb - TP + tk) * 1024 + hd * 128 + d]);
  }
  if (tid < 8) { av[tid] = __expf(p.gA[(size_t)(tb + tid) * 8 + hd]); bv[tid] = p.betaA[(size_t)(tb + tid) * 8 + hd]; }
  float S[64];
  const float* sp = p.stDelta + ((size_t)(sb * 8 + hd) * 128 + dh * 64) * 128 + e;
#pragma unroll
  for (int d0 = 0; d0 < 64; d0 += 4) {
    S[d0] = __builtin_nontemporal_load(sp); S[d0 + 1] = __builtin_nontemporal_load(sp + 128); S[d0 + 2] = __builtin_nontemporal_load(sp + 256); S[d0 + 3] = __builtin_nontemporal_load(sp + 384);
    sp += 512; asm volatile("" : "+v"(sp));
  }
  __syncthreads();
#pragma unroll 1
  for (int i = 0; i < 8; ++i) {
    const int t = tb + i;
    bf16_t* vp = p.VB + ((size_t)(t >> 2) * 1024 + hd * 128 + e) * 4 + (t & 3);
    const float v = bf2f(*vp), a = av[i], be = bv[i];
    const float* kr = ksm + i * 128 + dh * 64; const float* qr = qs + i * 128 + dh * 64;
    float kS = 0.f;
#pragma unroll
    for (int d4 = 0; d4 < 16; ++d4) {
      const float4 kk = *(const float4*)(kr + 4 * d4);
      kS += S[4 * d4] * kk.x; kS += S[4 * d4 + 1] * kk.y; kS += S[4 * d4 + 2] * kk.z; kS += S[4 * d4 + 3] * kk.w;
      if ((d4 & 7) == 7) __builtin_amdgcn_sched_barrier(0);
    }
    kS += __shfl_xor(kS, 1);
    const float uu = be * (v - a * kS);
    float oo = 0.f;
#pragma unroll
    for (int d4 = 0; d4 < 16; ++d4) {
      const float4 kk = *(const float4*)(kr + 4 * d4);
      const float4 qq = *(const float4*)(qr + 4 * d4);
      S[4 * d4] = a * S[4 * d4] + kk.x * uu; oo += S[4 * d4] * qq.x;
      S[4 * d4 + 1] = a * S[4 * d4 + 1] + kk.y * uu; oo += S[4 * d4 + 1] * qq.y;
      S[4 * d4 + 2] = a * S[4 * d4 + 2] + kk.z * uu; oo += S[4 * d4 + 2] * qq.z;
      S[4 * d4 + 3] = a * S[4 * d4 + 3] + kk.w * uu; oo += S[4 * d4 + 3] * qq.w;
      if ((d4 & 3) == 3) __builtin_amdgcn_sched_barrier(0);
    }
    oo += __shfl_xor(oo, 1);
    if (dh == 0 && !DRY) *vp = f2bf(oo);
  }
  float* dp = p.out + OFF_DELTAS + ((size_t)(sb * 8 + hd) * 128 + dh * 64) * 128 + e;
#pragma unroll
  for (int d0 = 0; d0 < 64; d0 += 4) {
    __builtin_nontemporal_store(S[d0], dp); __builtin_nontemporal_store(S[d0 + 1], dp + 128); __builtin_nontemporal_store(S[d0 + 2], dp + 256); __builtin_nontemporal_store(S[d0 + 3], dp + 384);
    dp += 512; asm volatile("" : "+v"(dp));
  }
  __syncthreads();
}
template <int MI, int NJ> DI void p4a_tile(const Params& p, int m0, int n0, char* smem) {
  f32x4 acc[MI][NJ]; zero_acc(acc);
  gemm_acc<MI, NJ>(acc, p.hbuf + (size_t)m0 * 1024, 1024, p.WinT + (size_t)(ROW_GA + n0) * 1024, 1024, 1024, smem);
  EPI_LOOP(
    const f32x4 v = acc[i][j];
    uint2 o; o.x = pk2(sigmoidf_(v[0]), sigmoidf_(v[1])); o.y = pk2(sigmoidf_(v[2]), sigmoidf_(v[3]));
    *(uint2*)(p.Y1 + (size_t)row * 1024 + col) = o;
  )
  zero_acc(acc);
  gemm_acc<MI, NJ>(acc, p.S0 + (size_t)m0 * 1024, 1024, p.PaT + (size_t)n0 * 1024, 1024, 1024, smem);
#pragma unroll
  for (int i = 0; i < MI; ++i) {
    uint2 stv[NJ];
    EPI_ROW(i, stv[j] = *(const uint2*)(p.Y1 + (size_t)row * 1024 + col); )
    EPI_ROW(i,
      const f32x4 v = acc[i][j];
      const uint2 st = stv[j];
      uint2 o; o.x = pk2(v[0] * bflo(st.x), v[1] * bfhi(st.x)); o.y = pk2(v[2] * bflo(st.y), v[3] * bfhi(st.y));
      *(uint2*)(p.Y1 + (size_t)row * 1024 + col) = o;
    )
  }
}
template <bool DRY> DI void phase4(const Params& p, char* smem) {
  if (blockIdx.x < 128) scan_unit<DRY>(p, blockIdx.x, smem);
#pragma unroll 1
  for (int pass = 0; pass < 2; ++pass) {
    const bool samples = (pass == 0) == (blockIdx.x < 256);
    if (samples) {
      while (true) {
        const int it = queue_next(p.ctr + (DRY ? 1 : 0), smem);
        if (it >= 1024) break;
        sample_item<DRY>(p, it, smem);
      }
    } else {
      while (true) {
        const int it = queue_next(p.ctr + 32 + (DRY ? 1 : 0), smem);
        if (it >= NT1K) break;
        int m0, n0;
        if (tile_1k(it, m0, n0)) p4a_tile<4, 8>(p, m0, n0, smem); else p4a_tile<2, 2>(p, m0, n0, smem);
      }
    }
  }
}
template <int MI, int NJ> DI void p5_tile(const Params& p, int m0, int n0, char* smem) {
  constexpr int BM = MI == 4 ? 128 : 32;
  f32x4 acc[MI][NJ]; zero_acc(acc);
  gemm_acc<MI, NJ>(acc, p.hbuf + (size_t)m0 * 1024, 1024, p.WinT + (size_t)(ROW_ZB + n0) * 1024, 1024, 1024, smem);
  float* rs = (float*)smem;
  constexpr int NH = NJ == 8 ? 2 : 1;
#pragma unroll
  for (int h2 = 0; h2 < NH; ++h2) {
    const int row = threadIdx.x >> 1, hf = threadIdx.x & 1, t = m0 + (row < BM ? row : 0);
    const bf16_t* op = p.VB + ((size_t)(t >> 2) * 1024 + n0 + h2 * 128 + hf * 64) * 4 + (t & 3);
    bf16_t ovr[64];
#pragma unroll
    for (int e = 0; e < 64; ++e) ovr[e] = op[e * 4];
    float ss = 0.f;
#pragma unroll
    for (int e = 0; e < 64; ++e) { const float v = bf2f(ovr[e]); ss += v * v; }
    ss += __shfl_xor(ss, 1);
    if (hf == 0 && row < BM) rs[h2 * BM + row] = rsqrtf(ss * (1.f / 128.f) + 1e-6f);
  }
  __syncthreads();
#pragma unroll
  for (int i = 0; i < MI; ++i) {
    bf16_t ov[NJ][4];
    EPI_ROW(i,
      const bf16_t* op = p.VB + ((size_t)(row >> 2) * 1024 + col) * 4 + (row & 3);
      _Pragma("unroll") for (int c = 0; c < 4; ++c) ov[j][c] = op[c * 4];
    )
    EPI_ROW(i,
      const f32x4 v = acc[i][j];
      const float rr = rs[((col - n0) >> 7) * BM + row - m0];
      const f32x4 hw = *(const f32x4*)(p.hnw + (col & 127));
      float y[4];
      _Pragma("unroll") for (int c = 0; c < 4; ++c) y[c] = bf2f(ov[j][c]) * rr * hw[c] * siluf_(v[c]);
      uint2 o; o.x = pk2(y[0], y[1]); o.y = pk2(y[2], y[3]);
      *(uint2*)(p.S0 + (size_t)row * 1024 + col) = o;
    )
  }
  __syncthreads();
}
DI void phase5(const Params& p, char* smem) {
  for (int it = blockIdx.x; it < NT1K; it += gridDim.x) {
    int m0, n0;
    if (tile_1k(it, m0, n0)) p5_tile<4, 8>(p, m0, n0, smem); else p5_tile<2, 2>(p, m0, n0, smem);
  }
}
template <int MI, int NJ> DI void p6_tile(const Params& p, int m0, int n0, char* smem) {
  f32x4 acc[MI][NJ]; zero_acc(acc);
    gemm_acc<MI, NJ>(acc, p.hbuf + (size_t)m0 * 1024, 1024, p.WinT + (size_t)(ROW_GB + n0) * 1024, 1024, 1024, smem);
    EPI_LOOP(
      const f32x4 v = acc[i][j];
      uint2 o; o.x = pk2(sigmoidf_(v[0]), sigmoidf_(v[1])); o.y = pk2(sigmoidf_(v[2]), sigmoidf_(v[3]));
      *(uint2*)(p.S1 + (size_t)row * 1024 + col) = o;
    )
    zero_acc(acc);
    gemm_acc<MI, NJ>(acc, p.S0 + (size_t)m0 * 1024, 1024, p.PbT + (size_t)n0 * 1024, 1024, 1024, smem);
#pragma unroll
  for (int i = 0; i < MI; ++i) {
    uint2 stv[NJ], mav[NJ];
    EPI_ROW(i, stv[j] = *(const uint2*)(p.S1 + (size_t)row * 1024 + col); mav[j] = *(const uint2*)(p.Y1 + (size_t)row * 1024 + col); )
    EPI_ROW(i,
      const f32x4 v = acc[i][j];
      const uint2 st = stv[j];
      const uint2 ma = mav[j];
      uint2 o;
      o.x = pk2(bflo(ma.x) + v[0] * bflo(st.x), bfhi(ma.x) + v[1] * bfhi(st.x));
      o.y = pk2(bflo(ma.y) + v[2] * bflo(st.y), bfhi(ma.y) + v[3] * bfhi(st.y));
      *(uint2*)(p.S1 + (size_t)row * 1024 + col) = o;
    )
  }
}
DI void phase6(const Params& p, char* smem) {
  for (int it = blockIdx.x; it < NT1K; it += gridDim.x) {
    int m0, n0;
    if (tile_1k(it, m0, n0)) p6_tile<4, 8>(p, m0, n0, smem); else p6_tile<2, 2>(p, m0, n0, smem);
  }
}
template <int MI, int NJ> DI void p7_tile(const Params& p, int m0, int n0, char* smem) {
  const float alpha = 1.189207115002721f;
  f32x4 acc[MI][NJ]; zero_acc(acc);
    gemm_acc<MI, NJ>(acc, p.S1 + (size_t)m0 * 1024, 1024, p.WoT + (size_t)n0 * 1024, 1024, 1024, smem);
#pragma unroll
  for (int i = 0; i < MI; ++i) {
    f32x4 gtv[NJ], xvv[NJ];
    EPI_ROW(i,
      gtv[j] = *(const f32x4*)(p.mod + (size_t)seq_of(row) * 3072 + 2048 + col);
      const float* xr = row < TP ? p.xP + (size_t)row * 1024 + col : p.xS + (size_t)(row - TP) * 1024 + col;
      xvv[j] = *(const f32x4*)xr;
    )
    EPI_ROW(i,
      const f32x4 v = acc[i][j];
      const f32x4 gt = gtv[j];
      const f32x4 xv = xvv[j];
      f32x4 rv;
      _Pragma("unroll") for (int c = 0; c < 4; ++c) rv[c] = alpha * xv[c] + (1.f + gt[c]) * v[c];
      *(f32x4*)(p.out + (size_t)row * 1024 + col) = rv;
    )
  }
}
DI void phase7(const Params& p, char* smem) {
  for (int it = blockIdx.x; it < NT1K; it += gridDim.x) {
    int m0, n0;
    if (tile_1k(it, m0, n0)) p7_tile<4, 8>(p, m0, n0, smem); else p7_tile<2, 2>(p, m0, n0, smem);
  }
}
DI void phase8(const Params& p) {
  int tid8 = threadIdx.x; asm volatile("" : "+v"(tid8));
  const int lane = tid8 & 63, wv = tid8 >> 6;
  const int stride = gridDim.x * 4;
  int row = blockIdx.x * 4 + wv;
  f32x4 v[4], n1[4], n2[4];
  if (row < TT) {
#pragma unroll
    for (int i = 0; i < 4; ++i) n1[i] = *(const f32x4*)(p.out + (size_t)row * 1024 + i * 256 + lane * 4);
  }
  if (row + stride < TT) {
#pragma unroll
    for (int i = 0; i < 4; ++i) n2[i] = *(const f32x4*)(p.out + (size_t)(row + stride) * 1024 + i * 256 + lane * 4);
  }
  f32x4 g[4], bb[4];
#pragma unroll
  for (int i = 0; i < 4; ++i) { g[i] = *(const f32x4*)(p.lnG + i * 256 + lane * 4); bb[i] = *(const f32x4*)(p.lnB + i * 256 + lane * 4); }
  for (; row < TT; row += stride) {
    float* rp = p.out + (size_t)row * 1024;
#pragma unroll
    for (int i = 0; i < 4; ++i) { v[i] = n1[i]; n1[i] = n2[i]; }
    if (row + 2 * stride < TT) {
#pragma unroll
      for (int i = 0; i < 4; ++i) n2[i] = *(const f32x4*)(rp + (size_t)(2 * stride) * 1024 + i * 256 + lane * 4);
    }
    float s = 0.f;
#pragma unroll
    for (int i = 0; i < 4; ++i) s += v[i][0] + v[i][1] + v[i][2] + v[i][3];
#pragma unroll
    for (int off = 1; off < 64; off <<= 1) s += __shfl_xor(s, off);
    const float mu = s * (1.f / 1024.f);
    float q = 0.f;
#pragma unroll
    for (int i = 0; i < 4; ++i)
#pragma unroll
      for (int c = 0; c < 4; ++c) { const float d = v[i][c] - mu; q += d * d; }
#pragma unroll
    for (int off = 1; off < 64; off <<= 1) q += __shfl_xor(q, off);
    const float rstd = rsqrtf(q * (1.f / 1024.f) + 1e-5f);
#pragma unroll
    for (int i = 0; i < 4; ++i) {
      f32x4 o;
#pragma unroll
      for (int c = 0; c < 4; ++c) o[c] = (v[i][c] - mu) * rstd * g[i][c] + bb[i][c];
      __builtin_nontemporal_store(o, (f32x4*)(rp + i * 256 + lane * 4));
    }
  }
}

DI void run_phase(const Params& p, int ph, char* smem) {
  switch (ph) {
    case 0: phase0(p, smem); break;
    case 1: phase0b(p); break;
    case 2: phase1(p, smem); break;
    case 3: phase2(p); break;
    case 4: phase3<false>(p, smem); break;
    case 5: phase4<false>(p, smem); break;
    case 6: phase5(p, smem); break;
    case 7: phase6(p, smem); break;
    case 8: phase7(p, smem); break;
    default: phase8(p); break;
  }
}
constexpr int NPHASE = 10;

#ifndef DUP
#define DUP -1
#endif
__global__ void __launch_bounds__(256, 2) fwd_mega(Params p) {
  __shared__ __attribute__((aligned(16))) char smem[SMEM_BYTES + 16];
  __shared__ uint4 xb_words;
  if (threadIdx.x == 0) xb_words = make_uint4(0u, 0u, 0u, 0u);
  __syncthreads();
  XcdBarrier xb = xcd_barrier_post(p.bar, (volatile LAS unsigned*)&xb_words);
  if (p.bar == nullptr) cg::this_grid().sync();
  phase0(p, smem); xcd_barrier(xb);
  if (DUP == 0) { phase0(p, smem); xcd_barrier(xb); }
  phase0b(p); xcd_barrier(xb);
  if (DUP == 1) { phase0b(p); xcd_barrier(xb); }
  phase1(p, smem); xcd_barrier(xb);
  if (DUP == 2) { phase1(p, smem); xcd_barrier(xb); }
  phase2(p); xcd_barrier(xb);
  if (DUP == 3) { phase2(p); xcd_barrier(xb); }
  if (DUP == 9) { for (int i = 0; i < 10; ++i) xcd_barrier(xb); }
  if (DUP == 4) { phase3<true>(p, smem); xcd_barrier(xb); }
  phase3<false>(p, smem); xcd_barrier(xb);
  if (DUP == 5) { phase4<true>(p, smem); xcd_barrier(xb); }
  phase4<false>(p, smem); xcd_barrier(xb);
  phase5(p, smem); xcd_barrier(xb);
  if (DUP == 6) { phase5(p, smem); xcd_barrier(xb); }
  phase6(p, smem); xcd_barrier(xb);
  if (DUP == 7) { phase6(p, smem); xcd_barrier(xb); }
  phase7(p, smem); xcd_barrier(xb);
  if (DUP == 8) { phase7(p, smem); xcd_barrier(xb); }
  phase8(p);
}
__global__ void __launch_bounds__(256, 2) fwd_phase(Params p, int ph) {
  __shared__ __attribute__((aligned(16))) char smem[SMEM_BYTES + 16];
  run_phase(p, ph, smem);
}

extern "C" void kernel_launch(void* const* d_in, const int* in_sizes, int n_in, void* d_out, int out_size, void* d_ws, size_t ws_size, hipStream_t stream) {
  Params p{};
  p.xP = (const float*)d_in[0]; p.xS = (const float*)d_in[1]; p.stPool = (const float*)d_in[2]; p.stConv = (const float*)d_in[3];
  p.stDelta = (const float*)d_in[4]; p.cP = (const float*)d_in[5]; p.cS = (const float*)d_in[6]; p.wAda = (const float*)d_in[7];
  p.bAda = (const float*)d_in[8]; p.wIn = (const float*)d_in[9]; p.convW = (const float*)d_in[10]; p.aLog = (const float*)d_in[11];
  p.dtBias = (const float*)d_in[12]; p.hnw = (const float*)d_in[13]; p.poolW = (const float*)d_in[14]; p.poolScale = (const float*)d_in[15];
  p.pA = (const float*)d_in[16]; p.pB = (const float*)d_in[17]; p.wOut = (const float*)d_in[18]; p.lnG = (const float*)d_in[19]; p.lnB = (const float*)d_in[20];
  p.out = (float*)d_out;
  char* w = (char*)d_ws; size_t off = 0;
  auto take = [&](size_t bytes) { char* r = w + off; off += (bytes + 255) & ~(size_t)255; return r; };
  p.WinT = (bf16_t*)take((size_t)WIN_ROWS * 1024 * 2);
  p.PwT = (bf16_t*)take(4 * 65536 * 2);
  p.PaT = (bf16_t*)take(1024 * 1024 * 2); p.PbT = (bf16_t*)take(1024 * 1024 * 2); p.WoT = (bf16_t*)take(1024 * 1024 * 2);
  p.mod = (float*)take((size_t)NSEQ * 3072 * 4);
  p.ctr = (unsigned*)take(256);
  p.bar = (unsigned*)take(XCD_BAR_WORDS * 4);
  p.praw = (float*)take((size_t)TT * 16 * 4);
  p.betaA = (float*)take((size_t)TT * 8 * 4); p.gA = (float*)take((size_t)TT * 8 * 4);
  p.glastA = (float*)take(16384 * 4);
  p.hbuf = (bf16_t*)take(GSZ * 2);
  p.S0 = (bf16_t*)take(GSZ * 2); p.S1 = (bf16_t*)take(GSZ * 2); p.S2 = (bf16_t*)take(GSZ * 2); p.S3 = (bf16_t*)take(GSZ * 2);
  p.VB = (bf16_t*)take(GSZ * 2);
  p.KS = (bf16_t*)take((size_t)TS * 1024 * 2);
  p.Y0 = (bf16_t*)d_out; p.Y1 = p.Y0 + GSZ;
  p.DS = (bf16_t*)((float*)d_out + OFF_DELTAS);
  if (off > ws_size) { fprintf(stderr, "workspace too small: need %zu have %zu\n", off, ws_size); return; }
  (void)hipMemsetAsync(p.ctr, 0, 256 + XCD_BAR_WORDS * 4, stream);
#if MEGA
  static int grid_blocks = 0;
  if (!grid_blocks) {
    int dev = 0, cus = 0, per_cu = 0;
    hipGetDevice(&dev);
    hipDeviceGetAttribute(&cus, hipDeviceAttributeMultiprocessorCount, dev);
    hipOccupancyMaxActiveBlocksPerMultiprocessor(&per_cu, fwd_mega, 256, 0);
    if (per_cu > 2) per_cu = 2;
    grid_blocks = cus * per_cu;
    grid_blocks &= ~7;
  }
  void* args[] = {&p};
  hipError_t e = hipLaunchCooperativeKernel((void*)fwd_mega, dim3(grid_blocks), dim3(256), args, 0, stream);
  if (e != hipSuccess) fprintf(stderr, "cooperative launch failed: %s (grid %d)\n", hipGetErrorString(e), grid_blocks);
#else
  for (int ph = 0; ph < NPHASE; ++ph) fwd_phase<<<512, 256, 0, stream>>>(p, ph);
#endif
}
```

```cpp
#include <hip/hip_runtime.h>
#include <hip/hip_cooperative_groups.h>
#include <stdint.h>
#include <cstdio>
namespace cg = cooperative_groups;

#ifndef MEGA
#define MEGA 1
#endif

typedef unsigned short bf16_t;
typedef short bf16x8 __attribute__((ext_vector_type(8)));
typedef short s16x4 __attribute__((ext_vector_type(4)));
typedef float f32x4 __attribute__((ext_vector_type(4)));
typedef float f32x2 __attribute__((ext_vector_type(2)));
typedef unsigned u32x4 __attribute__((ext_vector_type(4)));
typedef __bf16 bf2_t __attribute__((ext_vector_type(2)));
#define DI __device__ __forceinline__
#define MFMA16(a, b, c) __builtin_amdgcn_mfma_f32_16x16x32_bf16((a), (b), (c), 0, 0, 0)

constexpr int TP = 16384, TS = 1024, TT = 17408, DM = 1024, NSEQ = 136;
constexpr int NMT = 136;
constexpr int WIN_ROWS = 8320;
constexpr int ROW_ZA = 4224, ROW_ZB = 5248, ROW_GA = 6272, ROW_GB = 7296;
constexpr size_t GSZ = (size_t)TT * 1024;
constexpr size_t OFF_YP = 0, OFF_YS = 16777216, OFF_POOLP = 17825792, OFF_CONVP = 17948672, OFF_DELTAP = 18022400,
                 OFF_POOLS = 19070976, OFF_CONVS = 21037056, OFF_DELTAS = 22216704;
constexpr int SMEM_BYTES = 73728;
constexpr int LROW = 144, TILE_B = 128 * LROW;

struct Params {
  const float *xP, *xS, *stPool, *stConv, *stDelta, *cP, *cS, *wAda, *bAda, *wIn, *convW, *aLog, *dtBias, *hnw,
      *poolW, *poolScale, *pA, *pB, *wOut, *lnG, *lnB;
  float* out;
  bf16_t *WinT, *PwT, *PaT, *PbT, *WoT;
  float* mod;
  unsigned* ctr;
  unsigned* bar;
  float *praw, *betaA, *gA, *glastA;
  bf16_t *hbuf, *S0, *S1, *S2, *S3, *VB, *Y0, *Y1, *DS, *KS;
};

DI unsigned pk2(float a, float b) { f32x2 v = {a, b}; bf2_t r = __builtin_convertvector(v, bf2_t); return __builtin_bit_cast(unsigned, r); }
DI bf16_t f2bf(float a) { return (bf16_t)(pk2(a, 0.f) & 0xffffu); }
DI float bflo(unsigned u) { return __uint_as_float(u << 16); }
DI float bfhi(unsigned u) { return __uint_as_float(u & 0xffff0000u); }
DI float bf2f(bf16_t h) { return __uint_as_float((unsigned)h << 16); }
DI float sigmoidf_(float x) { return 1.f / (1.f + __expf(-x)); }
DI float siluf_(float x) { return x / (1.f + __expf(-x)); }
DI int seq_of(int t) { return t < TP ? (t >> 11) : 8 + ((t - TP) >> 3); }

DI void tile_map(int i, int num_n, int& mt, int& nt, int per_xcd = 17) {
  const int xcd = i & 7, seq = i >> 3, per = 8 * num_n;
  const int group = seq / per, first = group * 8, gsz = min(per_xcd - first, 8), rem = seq - group * per;
  mt = (first + rem % gsz) * 8 + xcd; nt = rem / gsz;
}


#define XB_TMO      128
#define XB_XCNT(j)  (256  + 64 * (j))
#define XB_XSUB(j)  (1280 + 64 * (j))
#define XB_XGEN(j)  (2304 + 64 * (j))
#define XB_TOP      3328
#define XB_TOPGEN   3392
#define XCD_BAR_WORDS 3456
#define XB_SPIN_CAP (1u << 18)
#define LAS __attribute__((address_space(3)))
DI unsigned xb_ld(unsigned* p) { return __hip_atomic_load(p, __ATOMIC_RELAXED, __HIP_MEMORY_SCOPE_AGENT); }
DI unsigned xb_add(unsigned* p, unsigned v) { return __hip_atomic_fetch_add(p, v, __ATOMIC_RELAXED, __HIP_MEMORY_SCOPE_AGENT); }
DI unsigned xb_xcc_id() { return (unsigned)__builtin_amdgcn_s_getreg((3 << 11) | 20) & 0xFu; }
#define XB_SPIN(cond, bar) do { unsigned _sp = 0; while (cond) { __builtin_amdgcn_s_sleep(1); \
    if ((++_sp & 255u) == 0u) { if (xb_ld(&(bar)[XB_TMO])) break; if (_sp > XB_SPIN_CAP) { atomicAdd(&(bar)[XB_TMO], 1u); break; } } } } while (0)
struct XcdBarrier { unsigned* bar; unsigned x; volatile LAS unsigned* st; };
DI XcdBarrier xcd_barrier_post(unsigned* bar, volatile LAS unsigned* st) {
  XcdBarrier b; b.bar = bar; b.x = xb_xcc_id(); b.st = st;
  if (threadIdx.x == 0) (void)xb_add(&bar[XB_XCNT(b.x)], 1u);
  return b;
}
DI void xcd_barrier_complete(unsigned* bar, unsigned x, unsigned& nloc, unsigned& nx) {
  const unsigned G = gridDim.x * gridDim.y * gridDim.z;
  unsigned sum, cnt, mine, sp = 0u;
  for (;;) {
    sum = 0u; cnt = 0u; mine = 0u;
#pragma unroll
    for (unsigned j = 0; j < 16; ++j) { const unsigned c = xb_ld(&bar[XB_XCNT(j)]); sum += c; cnt += (c > 0u) ? 1u : 0u; mine = (j == x) ? c : mine; }
    if (sum == G) break;
    __builtin_amdgcn_s_sleep(1);
    if ((++sp & 255u) == 0u) { if (xb_ld(&bar[XB_TMO])) break; if (sp > XB_SPIN_CAP) { atomicAdd(&bar[XB_TMO], 1u); break; } }
  }
  nloc = mine > 0u ? mine : 1u; nx = cnt > 0u ? cnt : 1u;
}
DI void xcd_barrier(const XcdBarrier& b) {
  asm volatile("s_waitcnt vmcnt(0)" ::: "memory");
  __syncthreads();
  if (threadIdx.x == 0) {
    unsigned* bar = b.bar;
    __builtin_amdgcn_s_waitcnt(0);
    unsigned nloc = b.st[0], nx = b.st[1];
    if (nloc == 0u) { xcd_barrier_complete(bar, b.x, nloc, nx); b.st[0] = nloc; b.st[1] = nx; }
    const unsigned old = xb_add(&bar[XB_XSUB(b.x)], 1u);
    const unsigned gen = old / nloc;
    if (old + 1u == (gen + 1u) * nloc) {
      __builtin_amdgcn_fence(__ATOMIC_RELEASE, "agent");
      asm volatile("s_waitcnt vmcnt(0)" ::: "memory");
      const unsigned og = xb_add(&bar[XB_TOP], 1u);
      const unsigned tg = og / nx;
      if (og + 1u == (tg + 1u) * nx) xb_add(&bar[XB_TOPGEN], 1u);
      else XB_SPIN(xb_ld(&bar[XB_TOPGEN]) == tg, bar);
      __builtin_amdgcn_fence(__ATOMIC_ACQUIRE, "agent");
      xb_add(&bar[XB_XGEN(b.x)], 1u);
      asm volatile("s_waitcnt vmcnt(0)" ::: "memory");
    } else {
      XB_SPIN(xb_ld(&bar[XB_XGEN(b.x)]) == gen, bar);
      __builtin_amdgcn_fence(__ATOMIC_ACQUIRE, "agent");
      asm volatile("s_waitcnt vmcnt(0)" ::: "memory");
    }
  }
  __syncthreads();
}

constexpr int NT1K = 768;
DI bool tile_1k(int it, int& m0, int& n0) {
  if (it < 512) { m0 = (it >> 2) * 128; n0 = (it & 3) * 256; return true; }
  const int s = it - 512; m0 = TP + (s >> 3) * 32; n0 = (s & 7) * 128; return false;
}

template <int MI, int NJ> DI void gemm_acc_std(f32x4 (&acc)[MI][NJ], const bf16_t* __restrict__ A, int lda, const bf16_t* __restrict__ Bt, int ldb, int K, char* smem) {
  int tid = threadIdx.x; asm volatile("" : "+v"(tid));
  constexpr int NA = MI == 4 ? 4 : 1;
  const int lane = tid & 63, wave = tid >> 6, wm = MI == 4 ? (wave >> 1) : 0, wn = MI == 4 ? (wave & 1) : wave;
  const int lr = tid >> 3, lc = (tid & 7) * 8;
  u32x4 ra0[4], rb0[4], ra1[4], rb1[4];
  unsigned aofs[4], bofs[4];
#pragma unroll
  for (int i = 0; i < 4; ++i) { aofs[i] = (unsigned)(((lr + 32 * i) * lda + lc) * 2); bofs[i] = (unsigned)(((lr + 32 * i) * ldb + lc) * 2); }
  const __amdgpu_buffer_rsrc_t rsA = __builtin_amdgcn_make_buffer_rsrc((void*)A, 0, 0x7fffffff, 0x00020000);
  const __amdgpu_buffer_rsrc_t rsB = __builtin_amdgcn_make_buffer_rsrc((void*)Bt, 0, 0x7fffffff, 0x00020000);
  const int aoff = (wm * 64 + (lane & 15)) * LROW + (lane >> 4) * 16;
  const int boff = TILE_B + (wn * 16 * NJ + (lane & 15)) * LROW + (lane >> 4) * 16;
  char* const st0 = smem + lr * LROW + lc * 2;
#define GLOAD(RA, RB, k0)                                                                                   \
  _Pragma("unroll") for (int i = 0; i < 4; ++i) {                                                          \
    if (i < NA) RA[i] = __builtin_amdgcn_raw_buffer_load_b128(rsA, aofs[i], (k0) * 2, 0);                   \
    RB[i] = __builtin_amdgcn_raw_buffer_load_b128(rsB, bofs[i], (k0) * 2, 0); }
#define LSTORE(RA, RB, buf)                                                                                 \
  _Pragma("unroll") for (int i = 0; i < 4; ++i) {                                                          \
    if (i < NA) *(u32x4*)(st0 + (buf) * 2 * TILE_B + 32 * i * LROW) = RA[i];                                \
    *(u32x4*)(st0 + (buf) * 2 * TILE_B + TILE_B + 32 * i * LROW) = RB[i]; }
#define COMPUTE(buf)                                                                                        \
  {                                                                                                         \
    const char* sbase = smem + (buf) * 2 * TILE_B;                                                          \
    _Pragma("unroll") for (int ks = 0; ks < 2; ++ks) {                                                      \
      bf16x8 af[MI], bfr[NJ];                                                                               \
      _Pragma("unroll") for (int i = 0; i < MI; ++i) af[i] = *(const bf16x8*)(sbase + aoff + i * 16 * LROW + ks * 64);   \
      _Pragma("unroll") for (int j = 0; j < NJ; ++j) bfr[j] = *(const bf16x8*)(sbase + boff + j * 16 * LROW + ks * 64);  \
      _Pragma("unroll") for (int i = 0; i < MI; ++i)                                                        \
        _Pragma("unroll") for (int j = 0; j < NJ; ++j) acc[i][j] = MFMA16(bfr[j], af[i], acc[i][j]);        \
      if (ks == 0) __builtin_amdgcn_sched_barrier(0);                                                       \
    }                                                                                                       \
  }
  GLOAD(ra0, rb0, 0)
  GLOAD(ra1, rb1, 64)
  LSTORE(ra0, rb0, 0)
  __syncthreads();
  const int nk = K >> 6;
#pragma unroll 1
  for (int kt = 0; kt < nk; kt += 2) {
    if (kt + 2 < nk) { GLOAD(ra0, rb0, (kt + 2) * 64) }
    __builtin_amdgcn_sched_barrier(0);
    COMPUTE(0)
    __builtin_amdgcn_sched_barrier(0);
    LSTORE(ra1, rb1, 1)
    __syncthreads();
    if (kt + 3 < nk) { GLOAD(ra1, rb1, (kt + 3) * 64) }
    __builtin_amdgcn_sched_barrier(0);
    COMPUTE(1)
    __builtin_amdgcn_sched_barrier(0);
    if (kt + 2 < nk) { LSTORE(ra0, rb0, 0) }
    __syncthreads();
  }
#undef GLOAD
#undef LSTORE
#undef COMPUTE
}

DI void gemm_wide(f32x4 (&acc)[4][8], const bf16_t* __restrict__ A, int lda, const bf16_t* __restrict__ Bt, int ldb, int K, char* smem) {
  int tid = threadIdx.x; asm volatile("" : "+v"(tid));
  const int lane = tid & 63, wave = tid >> 6, wm = wave >> 1, wn = wave & 1;
  const int lr = tid >> 3, lc = (tid & 7) * 8;
  u32x4 ra[4], rb[8];
  unsigned aofs[4], bofs[8];
#pragma unroll
  for (int i = 0; i < 4; ++i) aofs[i] = (unsigned)(((lr + 32 * i) * lda + lc) * 2);
#pragma unroll
  for (int i = 0; i < 8; ++i) bofs[i] = (unsigned)(((lr + 32 * i) * ldb + lc) * 2);
  const __amdgpu_buffer_rsrc_t rsA = __builtin_amdgcn_make_buffer_rsrc((void*)A, 0, 0x7fffffff, 0x00020000);
  const __amdgpu_buffer_rsrc_t rsB = __builtin_amdgcn_make_buffer_rsrc((void*)Bt, 0, 0x7fffffff, 0x00020000);
  const int aoff = (wm * 64 + (lane & 15)) * LROW + (lane >> 4) * 16;
  const int boff = TILE_B + (wn * 128 + (lane & 15)) * LROW + (lane >> 4) * 16;
  char* const st0 = smem + lr * LROW + lc * 2;
#define WLOAD(k0)                                                                                          \
  _Pragma("unroll") for (int i = 0; i < 4; ++i) ra[i] = __builtin_amdgcn_raw_buffer_load_b128(rsA, aofs[i], (k0) * 2, 0);  \
  _Pragma("unroll") for (int i = 0; i < 8; ++i) rb[i] = __builtin_amdgcn_raw_buffer_load_b128(rsB, bofs[i], (k0) * 2, 0);
#define WSTORE()                                                                                           \
  _Pragma("unroll") for (int i = 0; i < 4; ++i) *(u32x4*)(st0 + 32 * i * LROW) = ra[i];                     \
  _Pragma("unroll") for (int i = 0; i < 8; ++i) *(u32x4*)(st0 + TILE_B + 32 * i * LROW) = rb[i];
  WLOAD(0)
  WSTORE()
  __syncthreads();
  const int nk = K >> 6;
#pragma unroll 1
  for (int kt = 0; kt < nk; ++kt) {
    if (kt + 1 < nk) { WLOAD((kt + 1) * 64) }
    __builtin_amdgcn_sched_barrier(0);
#pragma unroll
    for (int ks = 0; ks < 2; ++ks) {
      bf16x8 af[4];
#pragma unroll
      for (int i = 0; i < 4; ++i) af[i] = *(const bf16x8*)(smem + aoff + i * 16 * LROW + ks * 64);
#pragma unroll
      for (int jh = 0; jh < 2; ++jh) {
        bf16x8 bfr[4];
#pragma unroll
        for (int j = 0; j < 4; ++j) bfr[j] = *(const bf16x8*)(smem + boff + (jh * 4 + j) * 16 * LROW + ks * 64);
#pragma unroll
        for (int i = 0; i < 4; ++i)
#pragma unroll
          for (int j = 0; j < 4; ++j) acc[i][jh * 4 + j] = MFMA16(bfr[j], af[i], acc[i][jh * 4 + j]);
        __builtin_amdgcn_sched_barrier(0);
      }
    }
    __syncthreads();
    if (kt + 1 < nk) { WSTORE() }
    __syncthreads();
  }
#undef WLOAD
#undef WSTORE
}
template <int MI, int NJ> DI void gemm_acc(f32x4 (&acc)[MI][NJ], const bf16_t* __restrict__ A, int lda, const bf16_t* __restrict__ Bt, int ldb, int K, char* smem) {
  if constexpr (NJ == 8) gemm_wide(acc, A, lda, Bt, ldb, K, smem); else gemm_acc_std<MI, NJ>(acc, A, lda, Bt, ldb, K, smem);
}
template <int MI, int NJ> DI void zero_acc(f32x4 (&acc)[MI][NJ]) {
#pragma unroll
  for (int i = 0; i < MI; ++i)
#pragma unroll
    for (int j = 0; j < NJ; ++j) acc[i][j] = (f32x4){0.f, 0.f, 0.f, 0.f};
}
#define EPI_LOOP(body)                                                                         \
  {                                                                                            \
    int tid_ = threadIdx.x; asm volatile("" : "+v"(tid_));                                    \
    const int lane_ = tid_ & 63, wave_ = tid_ >> 6;                                            \
    const int rb_ = m0 + (MI == 4 ? (wave_ >> 1) * 64 : 0) + (lane_ & 15);                     \
    const int cb_ = n0 + (MI == 4 ? (wave_ & 1) : wave_) * 16 * NJ + (lane_ >> 4) * 4;         \
    _Pragma("unroll") for (int i = 0; i < MI; ++i) _Pragma("unroll") for (int j = 0; j < NJ; ++j) { \
      const int row = rb_ + i * 16;                                                            \
      const int col = cb_ + j * 16;                                                            \
      body                                                                                     \
    }                                                                                          \
  }

#define EPI_ROW(i, body)                                                                       \
  {                                                                                            \
    int tid_ = threadIdx.x; asm volatile("" : "+v"(tid_));                                    \
    const int lane_ = tid_ & 63, wave_ = tid_ >> 6;                                            \
    const int row = m0 + (MI == 4 ? (wave_ >> 1) * 64 : 0) + (lane_ & 15) + (i) * 16;          \
    const int cb_ = n0 + (MI == 4 ? (wave_ & 1) : wave_) * 16 * NJ + (lane_ >> 4) * 4;         \
    _Pragma("unroll") for (int j = 0; j < NJ; ++j) {                                           \
      const int col = cb_ + j * 16;                                                            \
      body                                                                                     \
    }                                                                                          \
  }

DI int queue_next(unsigned* ctr, char* smem) {
  int* sitem = (int*)(smem + SMEM_BYTES);
  if (threadIdx.x == 0) *sitem = (int)atomicAdd(ctr, 1u);
  __syncthreads();
  const int it = *sitem;
  __syncthreads();
  return it;
}

DI void transpose_item(const float* __restrict__ src, int ldS, int col0, int ncols, int k0, bf16_t* __restrict__ dst, int ldD, int row0, char* smem) {
  float* tile = (float*)smem;
  int tid = threadIdx.x; asm volatile("" : "+v"(tid));
  const int tx = tid & 63, ty = tid >> 6;
  float v[32];
#pragma unroll
  for (int i = 0; i < 32; ++i) v[i] = (tx < ncols) ? src[(size_t)(k0 + ty + 4 * i) * ldS + col0 + tx] : 0.f;
#pragma unroll
  for (int i = 0; i < 32; ++i) tile[(ty + 4 * i) * 65 + tx] = v[i];
  __syncthreads();
  const int n = tid >> 2, ksg = (tid & 3) * 32;
  unsigned w[16];
#pragma unroll
  for (int i = 0; i < 16; ++i) w[i] = pk2(tile[(ksg + 2 * i) * 65 + n], tile[(ksg + 2 * i + 1) * 65 + n]);
  uint4* d = (uint4*)(dst + (size_t)(row0 + n) * ldD + k0 + ksg);
  d[0] = make_uint4(w[0], w[1], w[2], w[3]); d[1] = make_uint4(w[4], w[5], w[6], w[7]);
  d[2] = make_uint4(w[8], w[9], w[10], w[11]); d[3] = make_uint4(w[12], w[13], w[14], w[15]);
  __syncthreads();
}
DI void adaln_item(const Params& p, int it, char* smem) {
  const int cgp = it % 48, rg = it / 48, tid = threadIdx.x, lane = tid & 63, wv = tid >> 6;
  float* sc = (float*)smem;
#pragma unroll 1
  for (int kk = 0; kk < 4; ++kk) {
    const int k = tid + 256 * kk;
    float cv[16];
#pragma unroll
    for (int i = 0; i < 16; ++i) {
      const int sq = rg * 16 + i, sc_ = sq < NSEQ ? sq : NSEQ - 1;
      const float* rowp = sc_ < 8 ? p.cP + (size_t)sc_ * 1024 : p.cS + (size_t)(sc_ - 8) * 1024;
      cv[i] = rowp[k];
    }
#pragma unroll
    for (int i = 0; i < 16; ++i) sc[k * 16 + i] = (rg * 16 + i < NSEQ) ? siluf_(cv[i]) : 0.f;
  }
  __syncthreads();
  const int n = cgp * 64 + lane;
  float a[16];
#pragma unroll
  for (int i = 0; i < 16; ++i) a[i] = 0.f;
  const float* wp = p.wAda + (size_t)(wv * 256) * 3072 + n;
  const float* scp = sc + wv * 256 * 16;
#pragma unroll 1
  for (int k0 = 0; k0 < 256; k0 += 32) {
    float w[32];
#pragma unroll
    for (int u = 0; u < 32; ++u) w[u] = wp[(size_t)(k0 + u) * 3072];
#pragma unroll
    for (int u = 0; u < 32; ++u) {
#pragma unroll
      for (int q = 0; q < 4; ++q) {
        const float4 c = *(const float4*)(scp + (k0 + u) * 16 + 4 * q);
        a[4 * q] += w[u] * c.x; a[4 * q + 1] += w[u] * c.y; a[4 * q + 2] += w[u] * c.z; a[4 * q + 3] += w[u] * c.w;
      }
    }
  }
  __syncthreads();
  float* red = sc;
#pragma unroll
  for (int i = 0; i < 16; ++i) red[(wv * 16 + i) * 64 + lane] = a[i];
  __syncthreads();
  for (int o = tid; o < 1024; o += 256) {
    const int i = o >> 6, l = o & 63, nn = cgp * 64 + l, srow = rg * 16 + i;
    const float v = red[(0 * 16 + i) * 64 + l] + red[(1 * 16 + i) * 64 + l] + red[(2 * 16 + i) * 64 + l] + red[(3 * 16 + i) * 64 + l];
    if (srow < NSEQ) p.mod[(size_t)srow * 3072 + nn] = v + p.bAda[nn];
  }
  __syncthreads();
}
DI void phase0(const Params& p, char* smem) {
  const int NA = 432, NIT = NA + 1456;
  while (true) {
    const int it0 = queue_next(p.ctr + 2, smem);
    if (it0 >= NIT) break;
    if (it0 < NA) { adaln_item(p, it0, smem); continue; }
    const int it = it0 - NA;
    if (it < 1024) {
      const int grp = it >> 7, rem = it & 127, nt = rem >> 3, kt = rem & 7;
      const int srcb[8] = {0, 2048, 3072, 4096, 1024, 5120, 6160, 7184};
      const int dstb[8] = {0, 1024, 2048, 3072, ROW_ZA, ROW_ZB, ROW_GA, ROW_GB};
      int sb = 0, db = 0;
#pragma unroll
      for (int g = 0; g < 8; ++g) if (g == grp) { sb = srcb[g]; db = dstb[g]; }
      transpose_item(p.wIn, 8208, sb + nt * 64, 64, kt * 128, p.WinT, 1024, db + nt * 64, smem);
    } else if (it < 1040) {
      const int i2 = it - 1024, nt = i2 >> 3, kt = i2 & 7;
      transpose_item(p.wIn, 8208, 6144 + nt * 64, nt == 0 ? 16 : 0, kt * 128, p.WinT, 1024, 4096 + nt * 64, smem);
    } else if (it < 1072) {
      const int i3 = it - 1040, g = i3 >> 3, rem = i3 & 7, nt = rem >> 1, kt = rem & 1;
      transpose_item(p.poolW + g * 65536, 256, nt * 64, 64, kt * 128, p.PwT + g * 65536, 256, nt * 64, smem);
    } else {
      const int i4 = it - 1072, which = i4 >> 7, rem = i4 & 127, nt = rem >> 3, kt = rem & 7;
      const float* src = which == 0 ? p.pA : (which == 1 ? p.pB : p.wOut);
      bf16_t* dst = which == 0 ? p.PaT : (which == 1 ? p.PbT : p.WoT);
      transpose_item(src, 1024, nt * 64, 64, kt * 128, dst, 1024, nt * 64, smem);
    }
  }
}
DI void phase0b(const Params& p) {
  const int nvec = TT * 128;
  for (int v0 = blockIdx.x * 1024 + threadIdx.x; v0 < nvec; v0 += gridDim.x * 1024) {
    float4 x0[4], x1[4], sh0[4], sh1[4], sc0[4], sc1[4];
#pragma unroll
    for (int u = 0; u < 4; ++u) {
      const int v = v0 + u * 256, t = v >> 7, c = (v & 127) * 8;
      const float* xr = t < TP ? p.xP + (size_t)t * 1024 + c : p.xS + (size_t)(t - TP) * 1024 + c;
      const float* m = p.mod + (size_t)seq_of(t) * 3072 + c;
      x0[u] = *(const float4*)xr; x1[u] = *(const float4*)(xr + 4);
      sh0[u] = *(const float4*)m; sh1[u] = *(const float4*)(m + 4);
      sc0[u] = *(const float4*)(m + 1024); sc1[u] = *(const float4*)(m + 1028);
    }
#pragma unroll
    for (int u = 0; u < 4; ++u) {
      const int v = v0 + u * 256, t = v >> 7, c = (v & 127) * 8;
      uint4 o;
      o.x = pk2(x0[u].x * (1.f + sc0[u].x) + sh0[u].x, x0[u].y * (1.f + sc0[u].y) + sh0[u].y);
      o.y = pk2(x0[u].z * (1.f + sc0[u].z) + sh0[u].z, x0[u].w * (1.f + sc0[u].w) + sh0[u].w);
      o.z = pk2(x1[u].x * (1.f + sc1[u].x) + sh1[u].x, x1[u].y * (1.f + sc1[u].y) + sh1[u].y);
      o.w = pk2(x1[u].z * (1.f + sc1[u].z) + sh1[u].z, x1[u].w * (1.f + sc1[u].w) + sh1[u].w);
      *(uint4*)(p.hbuf + (size_t)t * 1024 + c) = o;
    }
  }
}
template <int MI, int NJ> DI void p1_tile(const Params& p, int m0, int n0, char* smem) {
  f32x4 acc[MI][NJ]; zero_acc(acc);
  gemm_acc<MI, NJ>(acc, p.hbuf + (size_t)m0 * 1024, 1024, p.WinT + (size_t)n0 * 1024, 1024, 1024, smem);
  EPI_LOOP(
    const f32x4 v = acc[i][j];
    if (col < 4096) { uint2 o; o.x = pk2(v[0], v[1]); o.y = pk2(v[2], v[3]); *(uint2*)(p.S0 + (size_t)row * 4096 + col) = o; }
    else if (col < 4112) { *(f32x4*)(p.praw + (size_t)row * 16 + (col - 4096)) = v; }
  )
}
DI void phase1(const Params& p, char* smem) {
  const int NW = NMT * 16, NIT = NW + NMT;
  for (int it = blockIdx.x; it < NIT; it += gridDim.x) {
    if (it < NW) p1_tile<4, 8>(p, (it >> 4) * 128, (it & 15) * 256, smem);
    else p1_tile<4, 4>(p, (it - NW) * 128, 4096, smem);
  }
}
template <int W> DI void pool_compute(const float (&r)[23][4], bool prompt, int p0, float (&po)[8][4]) {
#pragma unroll
  for (int i = 0; i < 8; ++i) {
    const float cnt = prompt ? (float)min(p0 + i + 1, W) : (float)W;
    const float inv = 1.f / cnt;
#pragma unroll
    for (int c = 0; c < 4; ++c) {
      float s = 0.f;
#pragma unroll
      for (int j = 0; j < W; ++j) s += r[15 + i - j][c];
      po[i][c] = s * inv - r[15 + i][c];
    }
  }
}
template <bool PROMPT> DI void p2_item(const Params& p, int gi) {
  const int tid = threadIdx.x, wave = tid >> 6, ch = tid * 4;
  constexpr bool prompt = PROMPT;
  int b = 0, p0 = 0, t0, sb = 0;
  if (prompt) { b = gi >> 8; p0 = (gi & 255) * 8; t0 = b * 2048 + p0; } else { sb = gi - 2048; t0 = TP + sb * 8; }
  const bf16_t* proj = p.S0;
  const bool wstate = (!prompt) || (p0 == 2040);
  const int gi_ = (tid & 63) >> 3, gh_ = tid & 7;
  const float braw_ = p.praw[(size_t)(t0 + gi_) * 16 + gh_], araw_ = p.praw[(size_t)(t0 + gi_) * 16 + 8 + gh_];
  const float dtb_ = p.dtBias[gh_], alg_ = p.aLog[gh_];
  {
    float r[23][4];
    {
      uint2 raw[23]; float4 rawf[15];
#pragma unroll
      for (int jj = 0; jj < 23; ++jj) {
        const int j = jj - 15;
        if (prompt) { const int jc = max(j, -p0); raw[jj] = *(const uint2*)(proj + (size_t)(t0 + jc) * 4096 + ch); }
        else if (j >= 0) raw[jj] = *(const uint2*)(proj + (size_t)(t0 + j) * 4096 + ch);
        else rawf[jj] = *(const float4*)(p.stPool + ((size_t)sb * 15 + jj) * 1024 + ch);
      }
#pragma unroll
      for (int jj = 0; jj < 23; ++jj) {
        const int j = jj - 15;
        if (prompt || j >= 0) {
          const float m = (!prompt || p0 + j >= 0) ? 1.f : 0.f;
          r[jj][0] = bflo(raw[jj].x) * m; r[jj][1] = bfhi(raw[jj].x) * m; r[jj][2] = bflo(raw[jj].y) * m; r[jj][3] = bfhi(raw[jj].y) * m;
        } else { r[jj][0] = rawf[jj].x; r[jj][1] = rawf[jj].y; r[jj][2] = rawf[jj].z; r[jj][3] = rawf[jj].w; }
      }
    }
    float po[8][4];
    if (wave == 0) pool_compute<2>(r, prompt, p0, po);
    else if (wave == 1) pool_compute<4>(r, prompt, p0, po);
    else if (wave == 2) pool_compute<8>(r, prompt, p0, po);
    else pool_compute<16>(r, prompt, p0, po);
#pragma unroll
    for (int i = 0; i < 8; ++i) { uint2 o; o.x = pk2(po[i][0], po[i][1]); o.y = pk2(po[i][2], po[i][3]); *(uint2*)(p.DS + (size_t)(t0 + i) * 1024 + ch) = o; }
    if (wstate) {
      float* dst = prompt ? p.out + OFF_POOLP + (size_t)b * 15 * 1024 : p.out + OFF_POOLS + (size_t)sb * 15 * 1024;
#pragma unroll
      for (int jj = 0; jj < 15; ++jj) *(float4*)(dst + jj * 1024 + ch) = make_float4(r[8 + jj][0], r[8 + jj][1], r[8 + jj][2], r[8 + jj][3]);
    }
  }
#pragma unroll
  for (int X = 0; X < 3; ++X) {
    const int cc = X * 1024 + ch;
    float v[11][4];
    {
      uint2 raw[11]; float4 rawf[3];
#pragma unroll
      for (int jj = 0; jj < 11; ++jj) {
        const int j = jj - 3;
        if (prompt) { const int jc = max(j, -p0); raw[jj] = *(const uint2*)(proj + (size_t)(t0 + jc) * 4096 + 1024 + cc); }
        else if (j >= 0) raw[jj] = *(const uint2*)(proj + (size_t)(t0 + j) * 4096 + 1024 + cc);
        else rawf[jj] = *(const float4*)(p.stConv + ((size_t)sb * 3 + jj) * 3072 + cc);
      }
#pragma unroll
      for (int jj = 0; jj < 11; ++jj) {
        const int j = jj - 3;
        if (prompt || j >= 0) {
          const float m = (!prompt || p0 + j >= 0) ? 1.f : 0.f;
          v[jj][0] = bflo(raw[jj].x) * m; v[jj][1] = bfhi(raw[jj].x) * m; v[jj][2] = bflo(raw[jj].y) * m; v[jj][3] = bfhi(raw[jj].y) * m;
        } else { v[jj][0] = rawf[jj].x; v[jj][1] = rawf[jj].y; v[jj][2] = rawf[jj].z; v[jj][3] = rawf[jj].w; }
      }
    }
    if (wstate) {
      float* dst = prompt ? p.out + OFF_CONVP + (size_t)b * 3 * 3072 : p.out + OFF_CONVS + (size_t)sb * 3 * 3072;
#pragma unroll
      for (int jj = 0; jj < 3; ++jj) *(float4*)(dst + jj * 3072 + cc) = make_float4(v[8 + jj][0], v[8 + jj][1], v[8 + jj][2], v[8 + jj][3]);
    }
    float cw[4][4];
#pragma unroll
    for (int m = 0; m < 4; ++m) { const float4 w = *(const float4*)(p.convW + m * 3072 + cc); cw[m][0] = w.x; cw[m][1] = w.y; cw[m][2] = w.z; cw[m][3] = w.w; }
    float o[8][4];
#pragma unroll
    for (int i = 0; i < 8; ++i) {
#pragma unroll
      for (int c = 0; c < 4; ++c) {
        const float s = cw[0][c] * v[i][c] + cw[1][c] * v[i + 1][c] + cw[2][c] * v[i + 2][c] + cw[3][c] * v[i + 3][c];
        o[i][c] = siluf_(s);
      }
      if (X < 2) {
        float ss = o[i][0] * o[i][0] + o[i][1] * o[i][1] + o[i][2] * o[i][2] + o[i][3] * o[i][3];
        ss += __shfl_xor(ss, 1); ss += __shfl_xor(ss, 2); ss += __shfl_xor(ss, 4); ss += __shfl_xor(ss, 8); ss += __shfl_xor(ss, 16);
        const float rn = rsqrtf(ss + 1e-6f) * (X == 0 ? 0.08838834764831845f : 1.f);
#pragma unroll
        for (int c = 0; c < 4; ++c) o[i][c] *= rn;
      }
    }
    if (X == 0) {
      if (prompt) {
        const int hd = tid >> 5, d = (tid & 31) * 4, ks = d >> 5, dd = d & 31, t_ = dd >> 4, kq = (dd & 15) >> 2;
        const int CH = ((b * 32 + (p0 >> 6)) * 8 + hd);
#pragma unroll
        for (int i2 = 0; i2 < 4; ++i2) {
          const int ia = 2 * i2, ib = 2 * i2 + 1;
          unsigned mx = pk2(o[t_ ? ia : ib][0], o[t_ ? ia : ib][1]), my = pk2(o[t_ ? ia : ib][2], o[t_ ? ia : ib][3]);
          const unsigned ox = (unsigned)__shfl_xor((int)mx, 4), oy = (unsigned)__shfl_xor((int)my, 4);
          const int i = t_ ? ib : ia;
          const unsigned kx = pk2(o[i][0], o[i][1]), ky = pk2(o[i][2], o[i][3]);
          uint4 w;
          if (t_ == 0) { w.x = kx; w.y = ky; w.z = ox; w.w = oy; } else { w.x = ox; w.y = oy; w.z = kx; w.w = ky; }
          const int c = (p0 & 63) + i, mt = c >> 4, r_ = c & 15;
          *(uint4*)(p.Y0 + (size_t)CH * 8192 + ((mt * 4 + ks) * 64 + kq * 16 + r_) * 8) = w;
        }
      } else {
#pragma unroll
        for (int i = 0; i < 8; ++i) { uint2 w; w.x = pk2(o[i][0], o[i][1]); w.y = pk2(o[i][2], o[i][3]); *(uint2*)(p.Y0 + (size_t)(t0 + i) * 1024 + ch) = w; }
      }
    } else if (X == 1) {
#pragma unroll
      for (int i = 0; i < 8; ++i) {
        uint2 w; w.x = pk2(o[i][0], o[i][1]); w.y = pk2(o[i][2], o[i][3]);
        bf16_t* kd = prompt ? p.Y1 + (size_t)(t0 + i) * 1024 + ch : p.KS + (size_t)(t0 - TP + i) * 1024 + ch;
        *(uint2*)kd = w;
      }
    } else {
#pragma unroll
      for (int g2 = 0; g2 < 2; ++g2) {
        uint4 w0, w1;
        w0.x = pk2(o[4 * g2][0], o[4 * g2 + 1][0]); w0.y = pk2(o[4 * g2 + 2][0], o[4 * g2 + 3][0]);
        w0.z = pk2(o[4 * g2][1], o[4 * g2 + 1][1]); w0.w = pk2(o[4 * g2 + 2][1], o[4 * g2 + 3][1]);
        w1.x = pk2(o[4 * g2][2], o[4 * g2 + 1][2]); w1.y = pk2(o[4 * g2 + 2][2], o[4 * g2 + 3][2]);
        w1.z = pk2(o[4 * g2][3], o[4 * g2 + 1][3]); w1.w = pk2(o[4 * g2 + 2][3], o[4 * g2 + 3][3]);
        uint4* dst = (uint4*)(p.VB + ((size_t)((t0 >> 2) + g2) * 1024 + ch) * 4);
        dst[0] = w0; dst[1] = w1;
      }
    }
  }
  if (tid < 64) {
    const int i = tid >> 3, hd = tid & 7;
    const float xx = araw_ + dtb_;
    const float sp = xx > 20.f ? xx : log1pf(__expf(xx));
    p.betaA[(size_t)(t0 + i) * 8 + hd] = sigmoidf_(braw_);
    p.gA[(size_t)(t0 + i) * 8 + hd] = -__expf(alg_) * sp;
  }
}
DI void phase2(const Params& p) {
  for (int it = blockIdx.x; it < 2176; it += gridDim.x) { const int gi = (it & 7) * 272 + (it >> 3); if (gi < 2048) p2_item<true>(p, gi); else p2_item<false>(p, gi); }
}
template <int MI, int NJ> DI void p3a_tile(const Params& p, int m0, int n0, char* smem) {
  f32x4 acc[MI][NJ]; zero_acc(acc);
  gemm_acc<MI, NJ>(acc, p.hbuf + (size_t)m0 * 1024, 1024, p.WinT + (size_t)(ROW_ZA + n0) * 1024, 1024, 1024, smem);
  EPI_LOOP(
    const f32x4 ps = *(const f32x4*)(p.poolScale + col);
    const f32x4 v = acc[i][j];
    uint2 o; o.x = pk2(siluf_(v[0]) * ps[0], siluf_(v[1]) * ps[1]); o.y = pk2(siluf_(v[2]) * ps[2], siluf_(v[3]) * ps[3]);
    *(uint2*)(p.S0 + (size_t)row * 1024 + col) = o;
  )
  zero_acc(acc);
  const int grp = n0 >> 8;
  gemm_acc<MI, NJ>(acc, p.DS + (size_t)m0 * 1024 + grp * 256, 1024, p.PwT + (size_t)grp * 65536 + (size_t)(n0 & 255) * 256, 256, 256, smem);
#pragma unroll
  for (int i = 0; i < MI; ++i) {
    uint2 stv[NJ];
    EPI_ROW(i, stv[j] = *(const uint2*)(p.S0 + (size_t)row * 1024 + col); )
    EPI_ROW(i,
      const f32x4 v = acc[i][j];
      const uint2 st = stv[j];
      uint2 o; o.x = pk2(v[0] * bflo(st.x), v[1] * bfhi(st.x)); o.y = pk2(v[2] * bflo(st.y), v[3] * bfhi(st.y));
      *(uint2*)(p.S0 + (size_t)row * 1024 + col) = o;
    )
  }
}
template <bool DRY> DI void p3b_item(const Params& p, int CH, char* smem) {
  int tid = threadIdx.x; asm volatile("" : "+v"(tid));
  const int lane = tid & 63, w = tid >> 6, r = lane & 15, kq = lane >> 4;
  const int hd = CH & 7, cn = CH >> 3, t0 = cn * 64;
  float* gcs = (float*)smem; float* bts = gcs + 64; float* Lm = bts + 64; char* ksm = (char*)(Lm + 4096);
  u32x4 kraw[4], qraw4[4];
  uint2 vraw[16];
  bf16_t* const vbase = p.VB + ((size_t)(t0 >> 2) * 1024 + hd * 128 + (tid & 127)) * 4;
#pragma unroll
  for (int i = 0; i < 4; ++i) {
    const int id = tid + 256 * i, row = id >> 4, c16 = id & 15;
    kraw[i] = *(const u32x4*)(p.Y1 + (size_t)(t0 + row) * 1024 + hd * 128 + c16 * 8);
  }
#pragma unroll
  for (int ks = 0; ks < 4; ++ks) qraw4[ks] = *(const u32x4*)(p.Y0 + (size_t)CH * 8192 + ((w * 4 + ks) * 64 + lane) * 8);
  const int tgb = t0 + (tid & 63);
  const float g_in = p.gA[(size_t)tgb * 8 + hd], b_in = p.betaA[(size_t)tgb * 8 + hd];
  if (tid < 128) {
#pragma unroll
    for (int i = 0; i < 16; ++i) vraw[i] = *(const uint2*)(vbase + (size_t)i * 4096);
  }
#pragma unroll
  for (int i = 0; i < 4; ++i) {
    const int id = tid + 256 * i, row = id >> 4, c16 = id & 15;
    *(u32x4*)(ksm + row * 272 + c16 * 16) = kraw[i];
  }
  if (tid < 64) {
    float g = g_in;
#pragma unroll
    for (int off = 1; off < 64; off <<= 1) { const float v = __shfl_up(g, off); if (lane >= off) g += v; }
    gcs[tid] = g; bts[tid] = b_in;
  }
  __syncthreads();
  const float gl = gcs[63];
  {
    f32x4 akk[4], aqk[4];
#pragma unroll
    for (int nt = 0; nt < 4; ++nt) { akk[nt] = (f32x4){0.f, 0.f, 0.f, 0.f}; aqk[nt] = (f32x4){0.f, 0.f, 0.f, 0.f}; }
    const float gam = __expf(gcs[16 * w + r]);
#pragma unroll
    for (int ks = 0; ks < 4; ++ks) {
      const bf16x8 ka = *(const bf16x8*)(ksm + (16 * w + r) * 272 + ks * 64 + kq * 16);
      bf16_t* qptr = p.Y0 + (size_t)CH * 8192 + ((w * 4 + ks) * 64 + lane) * 8;
      const uint4 qraw = make_uint4(qraw4[ks][0], qraw4[ks][1], qraw4[ks][2], qraw4[ks][3]);
      const bf16x8 qa = __builtin_bit_cast(bf16x8, qraw4[ks]);
#pragma unroll
      for (int nt = 0; nt < 4; ++nt) {
        const bf16x8 kb = *(const bf16x8*)(ksm + (16 * nt + r) * 272 + ks * 64 + kq * 16);
        const s16x4 lo = *(const s16x4*)(ksm + (16 * nt + r) * 272 + (32 * ks + 4 * kq) * 2);
        const s16x4 hi = *(const s16x4*)(ksm + (16 * nt + r) * 272 + (32 * ks + 16 + 4 * kq) * 2);
        const bf16x8 kbp = __builtin_shufflevector(lo, hi, 0, 1, 2, 3, 4, 5, 6, 7);
        akk[nt] = MFMA16(ka, kb, akk[nt]);
        aqk[nt] = MFMA16(qa, kbp, aqk[nt]);
      }
      uint4 qo;
      qo.x = pk2(bflo(qraw.x) * gam, bfhi(qraw.x) * gam); qo.y = pk2(bflo(qraw.y) * gam, bfhi(qraw.y) * gam);
      qo.z = pk2(bflo(qraw.z) * gam, bfhi(qraw.z) * gam); qo.w = pk2(bflo(qraw.w) * gam, bfhi(qraw.w) * gam);
      if (!DRY) *(uint4*)qptr = qo;
    }
#pragma unroll
    for (int nt = 0; nt < 4; ++nt)
#pragma unroll
      for (int j = 0; j < 4; ++j) {
        const int rr = 16 * w + 4 * kq + j, cc = 16 * nt + r;
        const float dec = __expf(fminf(gcs[rr] - gcs[cc], 0.f));
        Lm[rr * 64 + cc] = (cc < rr) ? bts[rr] * dec * akk[nt][j] : 0.f;
        const float qv = (cc <= rr) ? dec * aqk[nt][j] : 0.f;
        const int r3 = rr & 15, ks3 = cc >> 5, dd = cc & 31, t3 = dd >> 4, kq3 = (dd & 15) >> 2, j3 = dd & 3;
        p.S3[(size_t)CH * 4096 + ((w * 2 + ks3) * 64 + kq3 * 16 + r3) * 8 + 4 * t3 + j3] = f2bf(qv);
      }
  }
  __syncthreads();
  {
    float x[64];
    if (tid < 128) {
#pragma unroll
      for (int i = 0; i < 16; ++i) {
        const uint2 u = vraw[i];
        x[4 * i] = bts[4 * i] * bflo(u.x); x[4 * i + 1] = bts[4 * i + 1] * bfhi(u.x);
        x[4 * i + 2] = bts[4 * i + 2] * bflo(u.y); x[4 * i + 3] = bts[4 * i + 3] * bfhi(u.y);
      }
    } else {
      const int d = tid - 128;
#pragma unroll
      for (int rr = 0; rr < 64; ++rr) x[rr] = bts[rr] * __expf(gcs[rr]) * bf2f(*(const bf16_t*)(ksm + rr * 272 + d * 2));
    }
    {
      f32x4 la[12], lb[12], lt[4];
      la[0] = *(const f32x4*)(Lm + 64);
#pragma unroll
      for (int rr = 1; rr < 64; ++rr) {
        if (rr + 1 < 64) {
#pragma unroll
          for (int j4 = 0; j4 < (rr + 4) / 4 && j4 < 12; ++j4) {
            if (rr & 1) lb[j4] = *(const f32x4*)(Lm + (rr + 1) * 64 + 4 * j4); else la[j4] = *(const f32x4*)(Lm + (rr + 1) * 64 + 4 * j4);
          }
        }
#pragma unroll
        for (int j4 = 12; j4 < (rr + 3) / 4; ++j4) lt[j4 - 12] = *(const f32x4*)(Lm + rr * 64 + 4 * j4);
        __builtin_amdgcn_sched_barrier(0);
        float s0 = x[rr], s1 = 0.f;
#pragma unroll
        for (int j4 = 0; j4 < (rr + 3) / 4; ++j4) {
          const f32x4 l = j4 >= 12 ? lt[j4 - 12] : ((rr & 1) ? la[j4] : lb[j4]);
          s0 -= l[0] * x[4 * j4]; s1 -= l[1] * x[4 * j4 + 1]; s0 -= l[2] * x[4 * j4 + 2]; s1 -= l[3] * x[4 * j4 + 3];
        }
        x[rr] = s0 + s1;
        __builtin_amdgcn_sched_barrier(0);
      }
    }
    if (tid < 128) {
#pragma unroll
      for (int i = 0; i < 16; ++i) { uint2 u; u.x = pk2(x[4 * i], x[4 * i + 1]); u.y = pk2(x[4 * i + 2], x[4 * i + 3]); if (!DRY) *(uint2*)(vbase + (size_t)i * 4096) = u; }
    } else {
      const int d = tid - 128, ks_ = d >> 5, dd = d & 31, t_ = dd >> 4, kq_ = (dd & 15) >> 2, j_ = dd & 3;
      bf16_t* wk = p.S1 + (size_t)CH * 8192 + (ks_ * 64 + kq_ * 16) * 8 + 4 * t_ + j_;
#pragma unroll
      for (int rr = 0; rr < 64; ++rr) wk[((rr >> 4) * 4 * 64 + (rr & 15)) * 8] = f2bf(-x[rr]);
    }
  }
#pragma unroll
  for (int i = 0; i < 4; ++i) {
    const int slot = tid + 256 * i, f = slot >> 6, ln = slot & 63, mtp = f >> 1, ksp = f & 1, r2 = ln & 15, kq2 = ln >> 4;
    float vv[8];
#pragma unroll
    for (int t_ = 0; t_ < 2; ++t_)
#pragma unroll
      for (int j = 0; j < 4; ++j) {
        const int c = 32 * ksp + 16 * t_ + 4 * kq2 + j;
        vv[4 * t_ + j] = bf2f(*(const bf16_t*)(ksm + c * 272 + (16 * mtp + r2) * 2)) * __expf(gl - gcs[c]);
      }
    uint4 o; o.x = pk2(vv[0], vv[1]); o.y = pk2(vv[2], vv[3]); o.z = pk2(vv[4], vv[5]); o.w = pk2(vv[6], vv[7]);
    *(uint4*)(p.S2 + (size_t)CH * 8192 + (size_t)slot * 8) = o;
  }
  if (tid == 0) p.glastA[CH] = __expf(gl);
  __syncthreads();
}
template <bool DRY> DI void phase3(const Params& p, char* smem) {
#pragma unroll 1
  for (int pass = 0; pass < 2; ++pass) {
    const bool items = (pass == 0) == (blockIdx.x < 256);
    if (items) {
      while (true) {
        const int it = queue_next(p.ctr + 4, smem);
        if (it >= 2048) break;
        p3b_item<DRY>(p, it, smem);
      }
    } else {
      while (true) {
        const int it = queue_next(p.ctr + 5, smem);
        if (it >= NT1K) break;
        int m0, n0;
        if (tile_1k(it, m0, n0)) p3a_tile<4, 8>(p, m0, n0, smem); else p3a_tile<2, 2>(p, m0, n0, smem);
      }
    }
  }
}
DI bf16x8 pack8(const f32x4& a, const f32x4& b) {
  uint4 u; u.x = pk2(a[0], a[1]); u.y = pk2(a[2], a[3]); u.z = pk2(b[0], b[1]); u.w = pk2(b[2], b[3]);
  return __builtin_bit_cast(bf16x8, u);
}
struct ScanPre { u32x4 wk[4], qg[4], kt[4], qd[2]; uint2 wv[4]; float gl; };
DI void scan_prefetch(const Params& p, ScanPre& r, int chunk  , int hd, int tid, int rq, int ecol) {
  const size_t CH = (size_t)(chunk * 8 + hd);
#pragma unroll
  for (int i = 0; i < 4; ++i) {
    r.wk[i] = ((const u32x4*)(p.S1 + CH * 8192))[tid + 256 * i];
    r.qg[i] = ((const u32x4*)(p.Y0 + CH * 8192))[tid + 256 * i];
    r.kt[i] = ((const u32x4*)(p.S2 + CH * 8192))[tid + 256 * i];
  }
#pragma unroll
  for (int i = 0; i < 2; ++i) r.qd[i] = ((const u32x4*)(p.S3 + CH * 4096))[tid + 256 * i];
  const bf16_t* vb = p.VB + ((size_t)(chunk * 16 + rq) * 1024 + hd * 128 + ecol) * 4;
#pragma unroll
  for (int mt = 0; mt < 4; ++mt) r.wv[mt] = *(const uint2*)(vb + (size_t)(4 * mt) * 4096);
  r.gl = p.glastA[CH];
}
template <bool DRY> DI void scan_step(const Params& p, ScanPre& r, f32x4 (&S)[8], int chunk, bool more, int hd, int tid, int lane, int rq, int ecol, char* smem) {
  __syncthreads();
#pragma unroll
  for (int i = 0; i < 4; ++i) {
    ((u32x4*)smem)[tid + 256 * i] = r.wk[i];
    ((u32x4*)(smem + 16384))[tid + 256 * i] = r.qg[i];
    ((u32x4*)(smem + 32768))[tid + 256 * i] = r.kt[i];
  }
#pragma unroll
  for (int i = 0; i < 2; ++i) ((u32x4*)(smem + 49152))[tid + 256 * i] = r.qd[i];
  f32x4 u[4];
#pragma unroll
  for (int mt = 0; mt < 4; ++mt) u[mt] = (f32x4){bflo(r.wv[mt].x), bfhi(r.wv[mt].x), bflo(r.wv[mt].y), bfhi(r.wv[mt].y)};
  const float gl = r.gl;
  __syncthreads();
  if (more) scan_prefetch(p, r, chunk + 2, hd, tid, rq, ecol);
  bf16x8 Sb[4];
#pragma unroll
  for (int ks = 0; ks < 4; ++ks) Sb[ks] = pack8(S[2 * ks], S[2 * ks + 1]);
  f32x4 o[4];
#pragma unroll
  for (int mt = 0; mt < 4; ++mt) {
    o[mt] = (f32x4){0.f, 0.f, 0.f, 0.f};
#pragma unroll
    for (int ks = 0; ks < 4; ++ks) {
      const bf16x8 a = *(const bf16x8*)(smem + ((mt * 4 + ks) * 64 + lane) * 16);
      u[mt] = MFMA16(a, Sb[ks], u[mt]);
      const bf16x8 q = *(const bf16x8*)(smem + 16384 + ((mt * 4 + ks) * 64 + lane) * 16);
      o[mt] = MFMA16(q, Sb[ks], o[mt]);
    }
  }
  bf16x8 ub[2];
#pragma unroll
  for (int ks = 0; ks < 2; ++ks) ub[ks] = pack8(u[2 * ks], u[2 * ks + 1]);
#pragma unroll
  for (int mt = 0; mt < 4; ++mt)
#pragma unroll
    for (int ks = 0; ks < 2; ++ks) {
      const bf16x8 a = *(const bf16x8*)(smem + 49152 + ((mt * 2 + ks) * 64 + lane) * 16);
      o[mt] = MFMA16(a, ub[ks], o[mt]);
    }
#pragma unroll
  for (int mt = 0; mt < 8; ++mt) {
    S[mt] = S[mt] * gl;
#pragma unroll
    for (int ks = 0; ks < 2; ++ks) {
      const bf16x8 a = *(const bf16x8*)(smem + 32768 + ((mt * 2 + ks) * 64 + lane) * 16);
      S[mt] = MFMA16(a, ub[ks], S[mt]);
    }
  }
  bf16_t* vb = p.VB + ((size_t)(chunk * 16 + rq) * 1024 + hd * 128 + ecol) * 4;
#pragma unroll
  for (int mt = 0; mt < 4; ++mt) { uint2 v; v.x = pk2(o[mt][0], o[mt][1]); v.y = pk2(o[mt][2], o[mt][3]); if (!DRY) *(uint2*)(vb + (size_t)(4 * mt) * 4096) = v; }
}
template <bool DRY> DI void scan_unit(const Params& p, int unit, char* smem) {
  const int tid = threadIdx.x, lane = tid & 63, w = tid >> 6, col = lane & 15, rq = lane >> 4;
  const int bh = unit >> 1, b = bh >> 3, hd = bh & 7, e0 = ((unit & 1) * 4 + w) * 16, ecol = e0 + col;
  f32x4 S[8];
#pragma unroll
  for (int i = 0; i < 8; ++i) S[i] = (f32x4){0.f, 0.f, 0.f, 0.f};
  ScanPre ra, rb;
  scan_prefetch(p, ra, b * 32, hd, tid, rq, ecol);
  scan_prefetch(p, rb, b * 32 + 1, hd, tid, rq, ecol);
#pragma unroll 1
  for (int n = 0; n < 32; n += 2) {
    scan_step<DRY>(p, ra, S, b * 32 + n, n + 2 < 32, hd, tid, lane, rq, ecol, smem);
    scan_step<DRY>(p, rb, S, b * 32 + n + 1, n + 3 < 32, hd, tid, lane, rq, ecol, smem);
  }
  float* dp = p.out + OFF_DELTAP + ((size_t)bh * 128) * 128 + e0 + col;
#pragma unroll
  for (int mt = 0; mt < 8; ++mt)
#pragma unroll
    for (int j = 0; j < 4; ++j) dp[(size_t)(16 * mt + 4 * rq + j) * 128] = S[mt][j];
  __syncthreads();
}
template <bool DRY> DI void sample_item(const Params& p, int item, char* smem) {
  const int tid = threadIdx.x, e = tid >> 1, dh = tid & 1;
  const int sb = item >> 3, hd = item & 7, tb = TP + sb * 8;
  float* qs = (float*)smem; float* ksm = qs + 1024; float* av = ksm + 1024; float* bv = av + 8;
#pragma unroll
  for (int i = 0; i < 4; ++i) {
    const int id = tid + 256 * i, tk = id >> 7, d = id & 127;
    qs[id] = bf2f(p.Y0[(size_t)(tb + tk) * 1024 + hd * 128 + d]);
    ksm[id] = bf2f(p.KS[(size_t)(tb - TP + tk) * 1024 + hd * 128 + d]);
  }
  if (tid < 8) { av[tid] = __expf(p.gA[(size_t)(tb + tid) * 8 + hd]); bv[tid] = p.betaA[(size_t)(tb + tid) * 8 + hd]; }
  float S[64];
  const float* sp = p.stDelta + ((size_t)(sb * 8 + hd) * 128 + dh * 64) * 128 + e;
#pragma unroll
  for (int d0 = 0; d0 < 64; d0 += 4) {
    S[d0] = __builtin_nontemporal_load(sp); S[d0 + 1] = __builtin_nontemporal_load(sp + 128); S[d0 + 2] = __builtin_nontemporal_load(sp + 256); S[d0 + 3] = __builtin_nontemporal_load(sp + 384);
    sp += 512; asm volatile("" : "+v"(sp));
  }
  __syncthreads();
#pragma unroll 1
  for (int i = 0; i < 8; ++i) {
    const int t = tb + i;
    bf16_t* vp = p.VB + ((size_t)(t >> 2) * 1024 + hd * 128 + e) * 4 + (t & 3);
    const float v = bf2f(*vp), a = av[i], be = bv[i];
    const float* kr = ksm + i * 128 + dh * 64; const float* qr = qs + i * 128 + dh * 64;
    float kS = 0.f;
#pragma unroll
    for (int d4 = 0; d4 < 16; ++d4) {
      const float4 kk = *(const float4*)(kr + 4 * d4);
      kS += S[4 * d4] * kk.x; kS += S[4 * d4 + 1] * kk.y; kS += S[4 * d4 + 2] * kk.z; kS += S[4 * d4 + 3] * kk.w;
      if ((d4 & 3) == 3) __builtin_amdgcn_sched_barrier(0);
    }
    kS += __shfl_xor(kS, 1);
    const float uu = be * (v - a * kS);
    float oo = 0.f;
#pragma unroll
    for (int d4 = 0; d4 < 16; ++d4) {
      const float4 kk = *(const float4*)(kr + 4 * d4);
      const float4 qq = *(const float4*)(qr + 4 * d4);
      S[4 * d4] = a * S[4 * d4] + kk.x * uu; oo += S[4 * d4] * qq.x;
      S[4 * d4 + 1] = a * S[4 * d4 + 1] + kk.y * uu; oo += S[4 * d4 + 1] * qq.y;
      S[4 * d4 + 2] = a * S[4 * d4 + 2] + kk.z * uu; oo += S[4 * d4 + 2] * qq.z;
      S[4 * d4 + 3] = a * S[4 * d4 + 3] + kk.w * uu; oo += S[4 * d4 + 3] * qq.w;
      if ((d4 & 1) == 1) __builtin_amdgcn_sched_barrier(0);
    }
    oo += __shfl_xor(oo, 1);
    if (dh == 0 && !DRY) *vp = f2bf(oo);
  }
  float* dp = p.out + OFF_DELTAS + ((size_t)(sb * 8 + hd) * 128 + dh * 64) * 128 + e;
#pragma unroll
  for (int d0 = 0; d0 < 64; d0 += 4) {
    __builtin_nontemporal_store(S[d0], dp); __builtin_nontemporal_store(S[d0 + 1], dp + 128); __builtin_nontemporal_store(S[d0 + 2], dp + 256); __builtin_nontemporal_store(S[d0 + 3], dp + 384);
    dp += 512; asm volatile("" : "+v"(dp));
  }
  __syncthreads();
}
template <int MI, int NJ> DI void p4a_tile(const Params& p, int m0, int n0, char* smem) {
  f32x4 acc[MI][NJ]; zero_acc(acc);
  gemm_acc<MI, NJ>(acc, p.hbuf + (size_t)m0 * 1024, 1024, p.WinT + (size_t)(ROW_GA + n0) * 1024, 1024, 1024, smem);
  EPI_LOOP(
    const f32x4 v = acc[i][j];
    uint2 o; o.x = pk2(sigmoidf_(v[0]), sigmoidf_(v[1])); o.y = pk2(sigmoidf_(v[2]), sigmoidf_(v[3]));
    *(uint2*)(p.Y1 + (size_t)row * 1024 + col) = o;
  )
  zero_acc(acc);
  gemm_acc<MI, NJ>(acc, p.S0 + (size_t)m0 * 1024, 1024, p.PaT + (size_t)n0 * 1024, 1024, 1024, smem);
#pragma unroll
  for (int i = 0; i < MI; ++i) {
    uint2 stv[NJ];
    EPI_ROW(i, stv[j] = *(const uint2*)(p.Y1 + (size_t)row * 1024 + col); )
    EPI_ROW(i,
      const f32x4 v = acc[i][j];
      const uint2 st = stv[j];
      uint2 o; o.x = pk2(v[0] * bflo(st.x), v[1] * bfhi(st.x)); o.y = pk2(v[2] * bflo(st.y), v[3] * bfhi(st.y));
      *(uint2*)(p.Y1 + (size_t)row * 1024 + col) = o;
    )
  }
}
template <bool DRY> DI void phase4(const Params& p, char* smem) {
  if (blockIdx.x < 128) scan_unit<DRY>(p, blockIdx.x, smem);
#pragma unroll 1
  for (int pass = 0; pass < 2; ++pass) {
    const bool samples = (pass == 0) == (blockIdx.x < 256);
    if (samples) {
      while (true) {
        const int it = queue_next(p.ctr + (DRY ? 1 : 0), smem);
        if (it >= 1024) break;
        sample_item<DRY>(p, it, smem);
      }
    } else {
      while (true) {
        const int it = queue_next(p.ctr + 32 + (DRY ? 1 : 0), smem);
        if (it >= NT1K) break;
        int m0, n0;
        if (tile_1k(it, m0, n0)) p4a_tile<4, 8>(p, m0, n0, smem); else p4a_tile<2, 2>(p, m0, n0, smem);
      }
    }
  }
}
template <int MI, int NJ> DI void p5_tile(const Params& p, int m0, int n0, char* smem) {
  constexpr int BM = MI == 4 ? 128 : 32;
  f32x4 acc[MI][NJ]; zero_acc(acc);
  gemm_acc<MI, NJ>(acc, p.hbuf + (size_t)m0 * 1024, 1024, p.WinT + (size_t)(ROW_ZB + n0) * 1024, 1024, 1024, smem);
  float* rs = (float*)smem;
  constexpr int NH = NJ == 8 ? 2 : 1;
#pragma unroll
  for (int h2 = 0; h2 < NH; ++h2) {
    const int row = threadIdx.x >> 1, hf = threadIdx.x & 1, t = m0 + (row < BM ? row : 0);
    const bf16_t* op = p.VB + ((size_t)(t >> 2) * 1024 + n0 + h2 * 128 + hf * 64) * 4 + (t & 3);
    bf16_t ovr[64];
#pragma unroll
    for (int e = 0; e < 64; ++e) ovr[e] = op[e * 4];
    float ss = 0.f;
#pragma unroll
    for (int e = 0; e < 64; ++e) { const float v = bf2f(ovr[e]); ss += v * v; }
    ss += __shfl_xor(ss, 1);
    if (hf == 0 && row < BM) rs[h2 * BM + row] = rsqrtf(ss * (1.f / 128.f) + 1e-6f);
  }
  __syncthreads();
#pragma unroll
  for (int i = 0; i < MI; ++i) {
    bf16_t ov[NJ][4];
    EPI_ROW(i,
      const bf16_t* op = p.VB + ((size_t)(row >> 2) * 1024 + col) * 4 + (row & 3);
      _Pragma("unroll") for (int c = 0; c < 4; ++c) ov[j][c] = op[c * 4];
    )
    EPI_ROW(i,
      const f32x4 v = acc[i][j];
      const float rr = rs[((col - n0) >> 7) * BM + row - m0];
      const f32x4 hw = *(const f32x4*)(p.hnw + (col & 127));
      float y[4];
      _Pragma("unroll") for (int c = 0; c < 4; ++c) y[c] = bf2f(ov[j][c]) * rr * hw[c] * siluf_(v[c]);
      uint2 o; o.x = pk2(y[0], y[1]); o.y = pk2(y[2], y[3]);
      *(uint2*)(p.S0 + (size_t)row * 1024 + col) = o;
    )
  }
  __syncthreads();
}
DI void phase5(const Params& p, char* smem) {
  for (int it = blockIdx.x; it < NT1K; it += gridDim.x) {
    int m0, n0;
    if (tile_1k(it, m0, n0)) p5_tile<4, 8>(p, m0, n0, smem); else p5_tile<2, 2>(p, m0, n0, smem);
  }
}
template <int MI, int NJ> DI void p6_tile(const Params& p, int m0, int n0, char* smem) {
  f32x4 acc[MI][NJ]; zero_acc(acc);
    gemm_acc<MI, NJ>(acc, p.hbuf + (size_t)m0 * 1024, 1024, p.WinT + (size_t)(ROW_GB + n0) * 1024, 1024, 1024, smem);
    EPI_LOOP(
      const f32x4 v = acc[i][j];
      uint2 o; o.x = pk2(sigmoidf_(v[0]), sigmoidf_(v[1])); o.y = pk2(sigmoidf_(v[2]), sigmoidf_(v[3]));
      *(uint2*)(p.S1 + (size_t)row * 1024 + col) = o;
    )
    zero_acc(acc);
    gemm_acc<MI, NJ>(acc, p.S0 + (size_t)m0 * 1024, 1024, p.PbT + (size_t)n0 * 1024, 1024, 1024, smem);
#pragma unroll
  for (int i = 0; i < MI; ++i) {
    uint2 stv[NJ], mav[NJ];
    EPI_ROW(i, stv[j] = *(const uint2*)(p.S1 + (size_t)row * 1024 + col); mav[j] = *(const uint2*)(p.Y1 + (size_t)row * 1024 + col); )
    EPI_ROW(i,
      const f32x4 v = acc[i][j];
      const uint2 st = stv[j];
      const uint2 ma = mav[j];
      uint2 o;
      o.x = pk2(bflo(ma.x) + v[0] * bflo(st.x), bfhi(ma.x) + v[1] * bfhi(st.x));
      o.y = pk2(bflo(ma.y) + v[2] * bflo(st.y), bfhi(ma.y) + v[3] * bfhi(st.y));
      *(uint2*)(p.S1 + (size_t)row * 1024 + col) = o;
    )
  }
}
DI void phase6(const Params& p, char* smem) {
  for (int it = blockIdx.x; it < NT1K; it += gridDim.x) {
    int m0, n0;
    if (tile_1k(it, m0, n0)) p6_tile<4, 8>(p, m0, n0, smem); else p6_tile<2, 2>(p, m0, n0, smem);
  }
}
template <int MI, int NJ> DI void p7_tile(const Params& p, int m0, int n0, char* smem) {
  const float alpha = 1.189207115002721f;
  f32x4 acc[MI][NJ]; zero_acc(acc);
    gemm_acc<MI, NJ>(acc, p.S1 + (size_t)m0 * 1024, 1024, p.WoT + (size_t)n0 * 1024, 1024, 1024, smem);
#pragma unroll
  for (int i = 0; i < MI; ++i) {
    f32x4 gtv[NJ], xvv[NJ];
    EPI_ROW(i,
      gtv[j] = *(const f32x4*)(p.mod + (size_t)seq_of(row) * 3072 + 2048 + col);
      const float* xr = row < TP ? p.xP + (size_t)row * 1024 + col : p.xS + (size_t)(row - TP) * 1024 + col;
      xvv[j] = *(const f32x4*)xr;
    )
    EPI_ROW(i,
      const f32x4 v = acc[i][j];
      const f32x4 gt = gtv[j];
      const f32x4 xv = xvv[j];
      f32x4 rv;
      _Pragma("unroll") for (int c = 0; c < 4; ++c) rv[c] = alpha * xv[c] + (1.f + gt[c]) * v[c];
      *(f32x4*)(p.out + (size_t)row * 1024 + col) = rv;
    )
  }
}
DI void phase7(const Params& p, char* smem) {
  for (int it = blockIdx.x; it < NT1K; it += gridDim.x) {
    int m0, n0;
    if (tile_1k(it, m0, n0)) p7_tile<4, 8>(p, m0, n0, smem); else p7_tile<2, 2>(p, m0, n0, smem);
  }
}
DI void phase8(const Params& p) {
  int tid8 = threadIdx.x; asm volatile("" : "+v"(tid8));
  const int lane = tid8 & 63, wv = tid8 >> 6;
  const int stride = gridDim.x * 4;
  int row = blockIdx.x * 4 + wv;
  f32x4 v[4], n1[4], n2[4];
  if (row < TT) {
#pragma unroll
    for (int i = 0; i < 4; ++i) n1[i] = *(const f32x4*)(p.out + (size_t)row * 1024 + i * 256 + lane * 4);
  }
  if (row + stride < TT) {
#pragma unroll
    for (int i = 0; i < 4; ++i) n2[i] = *(const f32x4*)(p.out + (size_t)(row + stride) * 1024 + i * 256 + lane * 4);
  }
  f32x4 g[4], bb[4];
#pragma unroll
  for (int i = 0; i < 4; ++i) { g[i] = *(const f32x4*)(p.lnG + i * 256 + lane * 4); bb[i] = *(const f32x4*)(p.lnB + i * 256 + lane * 4); }
  for (; row < TT; row += stride) {
    float* rp = p.out + (size_t)row * 1024;
#pragma unroll
    for (int i = 0; i < 4; ++i) { v[i] = n1[i]; n1[i] = n2[i]; }
    if (row + 2 * stride < TT) {
#pragma unroll
      for (int i = 0; i < 4; ++i) n2[i] = *(const f32x4*)(rp + (size_t)(2 * stride) * 1024 + i * 256 + lane * 4);
    }
    float s = 0.f;
#pragma unroll
    for (int i = 0; i < 4; ++i) s += v[i][0] + v[i][1] + v[i][2] + v[i][3];
#pragma unroll
    for (int off = 1; off < 64; off <<= 1) s += __shfl_xor(s, off);
    const float mu = s * (1.f / 1024.f);
    float q = 0.f;
#pragma unroll
    for (int i = 0; i < 4; ++i)
#pragma unroll
      for (int c = 0; c < 4; ++c) { const float d = v[i][c] - mu; q += d * d; }
#pragma unroll
    for (int off = 1; off < 64; off <<= 1) q += __shfl_xor(q, off);
    const float rstd = rsqrtf(q * (1.f / 1024.f) + 1e-5f);
#pragma unroll
    for (int i = 0; i < 4; ++i) {
      f32x4 o;
#pragma unroll
      for (int c = 0; c < 4; ++c) o[c] = (v[i][c] - mu) * rstd * g[i][c] + bb[i][c];
      __builtin_nontemporal_store(o, (f32x4*)(rp + i * 256 + lane * 4));
    }
  }
}

DI void run_phase(const Params& p, int ph, char* smem) {
  switch (ph) {
    case 0: phase0(p, smem); break;
    case 1: phase0b(p); break;
    case 2: phase1(p, smem); break;
    case 3: phase2(p); break;
    case 4: phase3<false>(p, smem); break;
    case 5: phase4<false>(p, smem); break;
    case 6: phase5(p, smem); break;
    case 7: phase6(p, smem); break;
    case 8: phase7(p, smem); break;
    default: phase8(p); break;
  }
}
constexpr int NPHASE = 10;

#ifndef DUP
#define DUP -1
#endif
__global__ void __launch_bounds__(256, 2) fwd_mega(Params p) {
  __shared__ __attribute__((aligned(16))) char smem[SMEM_BYTES + 16];
  __shared__ uint4 xb_words;
  if (threadIdx.x == 0) xb_words = make_uint4(0u, 0u, 0u, 0u);
  __syncthreads();
  XcdBarrier xb = xcd_barrier_post(p.bar, (volatile LAS unsigned*)&xb_words);
  if (p.bar == nullptr) cg::this_grid().sync();
  phase0(p, smem); xcd_barrier(xb);
  if (DUP == 0) { phase0(p, smem); xcd_barrier(xb); }
  phase0b(p); xcd_barrier(xb);
  if (DUP == 1) { phase0b(p); xcd_barrier(xb); }
  phase1(p, smem); xcd_barrier(xb);
  if (DUP == 2) { phase1(p, smem); xcd_barrier(xb); }
  phase2(p); xcd_barrier(xb);
  if (DUP == 3) { phase2(p); xcd_barrier(xb); }
  if (DUP == 9) { for (int i = 0; i < 10; ++i) xcd_barrier(xb); }
  if (DUP == 4) { phase3<true>(p, smem); xcd_barrier(xb); }
  phase3<false>(p, smem); xcd_barrier(xb);
  if (DUP == 5) { phase4<true>(p, smem); xcd_barrier(xb); }
  phase4<false>(p, smem); xcd_barrier(xb);
  phase5(p, smem); xcd_barrier(xb);
  if (DUP == 6) { phase5(p, smem); xcd_barrier(xb); }
  phase6(p, smem); xcd_barrier(xb);
  if (DUP == 7) { phase6(p, smem); xcd_barrier(xb); }
  phase7(p, smem); xcd_barrier(xb);
  if (DUP == 8) { phase7(p, smem); xcd_barrier(xb); }
  phase8(p);
}
__global__ void __launch_bounds__(256, 2) fwd_phase(Params p, int ph) {
  __shared__ __attribute__((aligned(16))) char smem[SMEM_BYTES + 16];
  run_phase(p, ph, smem);
}

extern "C" void kernel_launch(void* const* d_in, const int* in_sizes, int n_in, void* d_out, int out_size, void* d_ws, size_t ws_size, hipStream_t stream) {
  Params p{};
  p.xP = (const float*)d_in[0]; p.xS = (const float*)d_in[1]; p.stPool = (const float*)d_in[2]; p.stConv = (const float*)d_in[3];
  p.stDelta = (const float*)d_in[4]; p.cP = (const float*)d_in[5]; p.cS = (const float*)d_in[6]; p.wAda = (const float*)d_in[7];
  p.bAda = (const float*)d_in[8]; p.wIn = (const float*)d_in[9]; p.convW = (const float*)d_in[10]; p.aLog = (const float*)d_in[11];
  p.dtBias = (const float*)d_in[12]; p.hnw = (const float*)d_in[13]; p.poolW = (const float*)d_in[14]; p.poolScale = (const float*)d_in[15];
  p.pA = (const float*)d_in[16]; p.pB = (const float*)d_in[17]; p.wOut = (const float*)d_in[18]; p.lnG = (const float*)d_in[19]; p.lnB = (const float*)d_in[20];
  p.out = (float*)d_out;
  char* w = (char*)d_ws; size_t off = 0;
  auto take = [&](size_t bytes) { char* r = w + off; off += (bytes + 255) & ~(size_t)255; return r; };
  p.WinT = (bf16_t*)take((size_t)WIN_ROWS * 1024 * 2);
  p.PwT = (bf16_t*)take(4 * 65536 * 2);
  p.PaT = (bf16_t*)take(1024 * 1024 * 2); p.PbT = (bf16_t*)take(1024 * 1024 * 2); p.WoT = (bf16_t*)take(1024 * 1024 * 2);
  p.mod = (float*)take((size_t)NSEQ * 3072 * 4);
  p.ctr = (unsigned*)take(256);
  p.bar = (unsigned*)take(XCD_BAR_WORDS * 4);
  p.praw = (float*)take((size_t)TT * 16 * 4);
  p.betaA = (float*)take((size_t)TT * 8 * 4); p.gA = (float*)take((size_t)TT * 8 * 4);
  p.glastA = (float*)take(16384 * 4);
  p.hbuf = (bf16_t*)take(GSZ * 2);
  p.S0 = (bf16_t*)take(GSZ * 2); p.S1 = (bf16_t*)take(GSZ * 2); p.S2 = (bf16_t*)take(GSZ * 2); p.S3 = (bf16_t*)take(GSZ * 2);
  p.VB = (bf16_t*)take(GSZ * 2);
  p.KS = (bf16_t*)take((size_t)TS * 1024 * 2);
  p.Y0 = (bf16_t*)d_out; p.Y1 = p.Y0 + GSZ;
  p.DS = (bf16_t*)((float*)d_out + OFF_DELTAS);
  if (off > ws_size) { fprintf(stderr, "workspace too small: need %zu have %zu\n", off, ws_size); return; }
  (void)hipMemsetAsync(p.ctr, 0, 256 + XCD_BAR_WORDS * 4, stream);
#if MEGA
  static int grid_blocks = 0;
  if (!grid_blocks) {
    int dev = 0, cus = 0, per_cu = 0;
    hipGetDevice(&dev);
    hipDeviceGetAttribute(&cus, hipDeviceAttributeMultiprocessorCount, dev);
    hipOccupancyMaxActiveBlocksPerMultiprocessor(&per_cu, fwd_mega, 256, 0);
    if (per_cu > 2) per_cu = 2;
    grid_blocks = cus * per_cu;
    grid_blocks &= ~7;
  }
  void* args[] = {&p};
  hipError_t e = hipLaunchCooperativeKernel((void*)fwd_mega, dim3(grid_blocks), dim3(256), args, 0, stream);
  if (e != hipSuccess) fprintf(stderr, "cooperative launch failed: %s (grid %d)\n", hipGetErrorString(e), grid_blocks);
#else
  for (int ph = 0; ph < NPHASE; ++ph) fwd_phase<<<512, 256, 0, stream>>>(p, ph);
#endif
}
```

```cpp
#include <hip/hip_runtime.h>
#include <hip/hip_cooperative_groups.h>
#include <stdint.h>
#include <cstdio>
namespace cg = cooperative_groups;

#ifndef MEGA
#define MEGA 1
#endif

typedef unsigned short bf16_t;
typedef short bf16x8 __attribute__((ext_vector_type(8)));
typedef short s16x4 __attribute__((ext_vector_type(4)));
typedef float f32x4 __attribute__((ext_vector_type(4)));
typedef float f32x2 __attribute__((ext_vector_type(2)));
typedef unsigned u32x4 __attribute__((ext_vector_type(4)));
typedef __bf16 bf2_t __attribute__((ext_vector_type(2)));
#define DI __device__ __forceinline__
#define MFMA16(a, b, c) __builtin_amdgcn_mfma_f32_16x16x32_bf16((a), (b), (c), 0, 0, 0)

constexpr int TP = 16384, TS = 1024, TT = 17408, DM = 1024, NSEQ = 136;
constexpr int NMT = 136;
constexpr int WIN_ROWS = 8320;
constexpr int ROW_ZA = 4224, ROW_ZB = 5248, ROW_GA = 6272, ROW_GB = 7296;
constexpr size_t GSZ = (size_t)TT * 1024;
constexpr size_t OFF_YP = 0, OFF_YS = 16777216, OFF_POOLP = 17825792, OFF_CONVP = 17948672, OFF_DELTAP = 18022400,
                 OFF_POOLS = 19070976, OFF_CONVS = 21037056, OFF_DELTAS = 22216704;
constexpr int SMEM_BYTES = 73728;
constexpr int LROW = 144, TILE_B = 128 * LROW;

struct Params {
  const float *xP, *xS, *stPool, *stConv, *stDelta, *cP, *cS, *wAda, *bAda, *wIn, *convW, *aLog, *dtBias, *hnw,
      *poolW, *poolScale, *pA, *pB, *wOut, *lnG, *lnB;
  float* out;
  bf16_t *WinT, *PwT, *PaT, *PbT, *WoT;
  float* mod;
  unsigned* ctr;
  unsigned* bar;
  float *praw, *betaA, *gA, *glastA;
  bf16_t *hbuf, *S0, *S1, *S2, *S3, *VB, *Y0, *Y1, *DS, *KS;
};

DI unsigned pk2(float a, float b) { f32x2 v = {a, b}; bf2_t r = __builtin_convertvector(v, bf2_t); return __builtin_bit_cast(unsigned, r); }
DI bf16_t f2bf(float a) { return (bf16_t)(pk2(a, 0.f) & 0xffffu); }
DI float bflo(unsigned u) { return __uint_as_float(u << 16); }
DI float bfhi(unsigned u) { return __uint_as_float(u & 0xffff0000u); }
DI float bf2f(bf16_t h) { return __uint_as_float((unsigned)h << 16); }
DI float sigmoidf_(float x) { return 1.f / (1.f + __expf(-x)); }
DI float siluf_(float x) { return x / (1.f + __expf(-x)); }
DI int seq_of(int t) { return t < TP ? (t >> 11) : 8 + ((t - TP) >> 3); }

DI void tile_map(int i, int num_n, int& mt, int& nt, int per_xcd = 17) {
  const int xcd = i & 7, seq = i >> 3, per = 8 * num_n;
  const int group = seq / per, first = group * 8, gsz = min(per_xcd - first, 8), rem = seq - group * per;
  mt = (first + rem % gsz) * 8 + xcd; nt = rem / gsz;
}


#define XB_TMO      128
#define XB_XCNT(j)  (256  + 64 * (j))
#define XB_XSUB(j)  (1280 + 64 * (j))
#define XB_XGEN(j)  (2304 + 64 * (j))
#define XB_TOP      3328
#define XB_TOPGEN   3392
#define XCD_BAR_WORDS 3456
#define XB_SPIN_CAP (1u << 18)
#define LAS __attribute__((address_space(3)))
DI unsigned xb_ld(unsigned* p) { return __hip_atomic_load(p, __ATOMIC_RELAXED, __HIP_MEMORY_SCOPE_AGENT); }
DI unsigned xb_add(unsigned* p, unsigned v) { return __hip_atomic_fetch_add(p, v, __ATOMIC_RELAXED, __HIP_MEMORY_SCOPE_AGENT); }
DI unsigned xb_xcc_id() { return (unsigned)__builtin_amdgcn_s_getreg((3 << 11) | 20) & 0xFu; }
#define XB_SPIN(cond, bar) do { unsigned _sp = 0; while (cond) { __builtin_amdgcn_s_sleep(1); \
    if ((++_sp & 255u) == 0u) { if (xb_ld(&(bar)[XB_TMO])) break; if (_sp > XB_SPIN_CAP) { atomicAdd(&(bar)[XB_TMO], 1u); break; } } } } while (0)
struct XcdBarrier { unsigned* bar; unsigned x; volatile LAS unsigned* st; };
DI XcdBarrier xcd_barrier_post(unsigned* bar, volatile LAS unsigned* st) {
  XcdBarrier b; b.bar = bar; b.x = xb_xcc_id(); b.st = st;
  if (threadIdx.x == 0) (void)xb_add(&bar[XB_XCNT(b.x)], 1u);
  return b;
}
DI void xcd_barrier_complete(unsigned* bar, unsigned x, unsigned& nloc, unsigned& nx) {
  const unsigned G = gridDim.x * gridDim.y * gridDim.z;
  unsigned sum, cnt, mine, sp = 0u;
  for (;;) {
    sum = 0u; cnt = 0u; mine = 0u;
#pragma unroll
    for (unsigned j = 0; j < 16; ++j) { const unsigned c = xb_ld(&bar[XB_XCNT(j)]); sum += c; cnt += (c > 0u) ? 1u : 0u; mine = (j == x) ? c : mine; }
    if (sum == G) break;
    __builtin_amdgcn_s_sleep(1);
    if ((++sp & 255u) == 0u) { if (xb_ld(&bar[XB_TMO])) break; if (sp > XB_SPIN_CAP) { atomicAdd(&bar[XB_TMO], 1u); break; } }
  }
  nloc = mine > 0u ? mine : 1u; nx = cnt > 0u ? cnt : 1u;
}
DI void xcd_barrier(const XcdBarrier& b) {
  asm volatile("s_waitcnt vmcnt(0)" ::: "memory");
  __syncthreads();
  if (threadIdx.x == 0) {
    unsigned* bar = b.bar;
    __builtin_amdgcn_s_waitcnt(0);
    unsigned nloc = b.st[0], nx = b.st[1];
    if (nloc == 0u) { xcd_barrier_complete(bar, b.x, nloc, nx); b.st[0] = nloc; b.st[1] = nx; }
    const unsigned old = xb_add(&bar[XB_XSUB(b.x)], 1u);
    const unsigned gen = old / nloc;
    if (old + 1u == (gen + 1u) * nloc) {
      __builtin_amdgcn_fence(__ATOMIC_RELEASE, "agent");
      asm volatile("s_waitcnt vmcnt(0)" ::: "memory");
      const unsigned og = xb_add(&bar[XB_TOP], 1u);
      const unsigned tg = og / nx;
      if (og + 1u == (tg + 1u) * nx) xb_add(&bar[XB_TOPGEN], 1u);
      else XB_SPIN(xb_ld(&bar[XB_TOPGEN]) == tg, bar);
      __builtin_amdgcn_fence(__ATOMIC_ACQUIRE, "agent");
      xb_add(&bar[XB_XGEN(b.x)], 1u);
      asm volatile("s_waitcnt vmcnt(0)" ::: "memory");
    } else {
      XB_SPIN(xb_ld(&bar[XB_XGEN(b.x)]) == gen, bar);
      __builtin_amdgcn_fence(__ATOMIC_ACQUIRE, "agent");
      asm volatile("s_waitcnt vmcnt(0)" ::: "memory");
    }
  }
  __syncthreads();
}

constexpr int NT1K = 768;
DI bool tile_1k(int it, int& m0, int& n0) {
  if (it < 512) { m0 = (it >> 2) * 128; n0 = (it & 3) * 256; return true; }
  const int s = it - 512; m0 = TP + (s >> 3) * 32; n0 = (s & 7) * 128; return false;
}

template <int MI, int NJ> DI void gemm_acc_std(f32x4 (&acc)[MI][NJ], const bf16_t* __restrict__ A, int lda, const bf16_t* __restrict__ Bt, int ldb, int K, char* smem) {
  int tid = threadIdx.x; asm volatile("" : "+v"(tid));
  constexpr int NA = MI == 4 ? 4 : 1;
  const int lane = tid & 63, wave = tid >> 6, wm = MI == 4 ? (wave >> 1) : 0, wn = MI == 4 ? (wave & 1) : wave;
  const int lr = tid >> 3, lc = (tid & 7) * 8;
  u32x4 ra0[4], rb0[4], ra1[4], rb1[4];
  unsigned aofs[4], bofs[4];
#pragma unroll
  for (int i = 0; i < 4; ++i) { aofs[i] = (unsigned)(((lr + 32 * i) * lda + lc) * 2); bofs[i] = (unsigned)(((lr + 32 * i) * ldb + lc) * 2); }
  const __amdgpu_buffer_rsrc_t rsA = __builtin_amdgcn_make_buffer_rsrc((void*)A, 0, 0x7fffffff, 0x00020000);
  const __amdgpu_buffer_rsrc_t rsB = __builtin_amdgcn_make_buffer_rsrc((void*)Bt, 0, 0x7fffffff, 0x00020000);
  const int aoff = (wm * 64 + (lane & 15)) * LROW + (lane >> 4) * 16;
  const int boff = TILE_B + (wn * 16 * NJ + (lane & 15)) * LROW + (lane >> 4) * 16;
  char* const st0 = smem + lr * LROW + lc * 2;
#define GLOAD(RA, RB, k0)                                                                                   \
  _Pragma("unroll") for (int i = 0; i < 4; ++i) {                                                          \
    if (i < NA) RA[i] = __builtin_amdgcn_raw_buffer_load_b128(rsA, aofs[i], (k0) * 2, 0);                   \
    RB[i] = __builtin_amdgcn_raw_buffer_load_b128(rsB, bofs[i], (k0) * 2, 0); }
#define LSTORE(RA, RB, buf)                                                                                 \
  _Pragma("unroll") for (int i = 0; i < 4; ++i) {                                                          \
    if (i < NA) *(u32x4*)(st0 + (buf) * 2 * TILE_B + 32 * i * LROW) = RA[i];                                \
    *(u32x4*)(st0 + (buf) * 2 * TILE_B + TILE_B + 32 * i * LROW) = RB[i]; }
#define COMPUTE(buf)                                                                                        \
  {                                                                                                         \
    const char* sbase = smem + (buf) * 2 * TILE_B;                                                          \
    _Pragma("unroll") for (int ks = 0; ks < 2; ++ks) {                                                      \
      bf16x8 af[MI], bfr[NJ];                                                                               \
      _Pragma("unroll") for (int i = 0; i < MI; ++i) af[i] = *(const bf16x8*)(sbase + aoff + i * 16 * LROW + ks * 64);   \
      _Pragma("unroll") for (int j = 0; j < NJ; ++j) bfr[j] = *(const bf16x8*)(sbase + boff + j * 16 * LROW + ks * 64);  \
      _Pragma("unroll") for (int i = 0; i < MI; ++i)                                                        \
        _Pragma("unroll") for (int j = 0; j < NJ; ++j) acc[i][j] = MFMA16(bfr[j], af[i], acc[i][j]);        \
      if (ks == 0) __builtin_amdgcn_sched_barrier(0);                                                       \
    }                                                                                                       \
  }
  GLOAD(ra0, rb0, 0)
  GLOAD(ra1, rb1, 64)
  LSTORE(ra0, rb0, 0)
  __syncthreads();
  const int nk = K >> 6;
#pragma unroll 1
  for (int kt = 0; kt < nk; kt += 2) {
    if (kt + 2 < nk) { GLOAD(ra0, rb0, (kt + 2) * 64) }
    __builtin_amdgcn_sched_barrier(0);
    COMPUTE(0)
    __builtin_amdgcn_sched_barrier(0);
    LSTORE(ra1, rb1, 1)
    __syncthreads();
    if (kt + 3 < nk) { GLOAD(ra1, rb1, (kt + 3) * 64) }
    __builtin_amdgcn_sched_barrier(0);
    COMPUTE(1)
    __builtin_amdgcn_sched_barrier(0);
    if (kt + 2 < nk) { LSTORE(ra0, rb0, 0) }
    __syncthreads();
  }
#undef GLOAD
#undef LSTORE
#undef COMPUTE
}

DI void gemm_wide(f32x4 (&acc)[4][8], const bf16_t* __restrict__ A, int lda, const bf16_t* __restrict__ Bt, int ldb, int K, char* smem) {
  int tid = threadIdx.x; asm volatile("" : "+v"(tid));
  const int lane = tid & 63, wave = tid >> 6, wm = wave >> 1, wn = wave & 1;
  const int lr = tid >> 3, lc = (tid & 7) * 8;
  u32x4 ra[4], rb[8];
  unsigned aofs[4], bofs[8];
#pragma unroll
  for (int i = 0; i < 4; ++i) aofs[i] = (unsigned)(((lr + 32 * i) * lda + lc) * 2);
#pragma unroll
  for (int i = 0; i < 8; ++i) bofs[i] = (unsigned)(((lr + 32 * i) * ldb + lc) * 2);
  const __amdgpu_buffer_rsrc_t rsA = __builtin_amdgcn_make_buffer_rsrc((void*)A, 0, 0x7fffffff, 0x00020000);
  const __amdgpu_buffer_rsrc_t rsB = __builtin_amdgcn_make_buffer_rsrc((void*)Bt, 0, 0x7fffffff, 0x00020000);
  const int aoff = (wm * 64 + (lane & 15)) * LROW + (lane >> 4) * 16;
  const int boff = TILE_B + (wn * 128 + (lane & 15)) * LROW + (lane >> 4) * 16;
  char* const st0 = smem + lr * LROW + lc * 2;
#define WLOAD(k0)                                                                                          \
  _Pragma("unroll") for (int i = 0; i < 4; ++i) ra[i] = __builtin_amdgcn_raw_buffer_load_b128(rsA, aofs[i], (k0) * 2, 0);  \
  _Pragma("unroll") for (int i = 0; i < 8; ++i) rb[i] = __builtin_amdgcn_raw_buffer_load_b128(rsB, bofs[i], (k0) * 2, 0);
#define WSTORE()                                                                                           \
  _Pragma("unroll") for (int i = 0; i < 4; ++i) *(u32x4*)(st0 + 32 * i * LROW) = ra[i];                     \
  _Pragma("unroll") for (int i = 0; i < 8; ++i) *(u32x4*)(st0 + TILE_B + 32 * i * LROW) = rb[i];
  WLOAD(0)
  WSTORE()
  __syncthreads();
  const int nk = K >> 6;
#pragma unroll 1
  for (int kt = 0; kt < nk; ++kt) {
    if (kt + 1 < nk) { WLOAD((kt + 1) * 64) }
    __builtin_amdgcn_sched_barrier(0);
#pragma unroll
    for (int ks = 0; ks < 2; ++ks) {
      bf16x8 af[4];
#pragma unroll
      for (int i = 0; i < 4; ++i) af[i] = *(const bf16x8*)(smem + aoff + i * 16 * LROW + ks * 64);
#pragma unroll
      for (int jh = 0; jh < 2; ++jh) {
        bf16x8 bfr[4];
#pragma unroll
        for (int j = 0; j < 4; ++j) bfr[j] = *(const bf16x8*)(smem + boff + (jh * 4 + j) * 16 * LROW + ks * 64);
#pragma unroll
        for (int i = 0; i < 4; ++i)
#pragma unroll
          for (int j = 0; j < 4; ++j) acc[i][jh * 4 + j] = MFMA16(bfr[j], af[i], acc[i][jh * 4 + j]);
        __builtin_amdgcn_sched_barrier(0);
      }
    }
    __syncthreads();
    if (kt + 1 < nk) { WSTORE() }
    __syncthreads();
  }
#undef WLOAD
#undef WSTORE
}
template <int MI, int NJ> DI void gemm_acc(f32x4 (&acc)[MI][NJ], const bf16_t* __restrict__ A, int lda, const bf16_t* __restrict__ Bt, int ldb, int K, char* smem) {
  if constexpr (NJ == 8) gemm_wide(acc, A, lda, Bt, ldb, K, smem); else gemm_acc_std<MI, NJ>(acc, A, lda, Bt, ldb, K, smem);
}
template <int MI, int NJ> DI void zero_acc(f32x4 (&acc)[MI][NJ]) {
#pragma unroll
  for (int i = 0; i < MI; ++i)
#pragma unroll
    for (int j = 0; j < NJ; ++j) acc[i][j] = (f32x4){0.f, 0.f, 0.f, 0.f};
}
#define EPI_LOOP(body)                                                                         \
  {                                                                                            \
    int tid_ = threadIdx.x; asm volatile("" : "+v"(tid_));                                    \
    const int lane_ = tid_ & 63, wave_ = tid_ >> 6;                                            \
    const int rb_ = m0 + (MI == 4 ? (wave_ >> 1) * 64 : 0) + (lane_ & 15);                     \
    const int cb_ = n0 + (MI == 4 ? (wave_ & 1) : wave_) * 16 * NJ + (lane_ >> 4) * 4;         \
    _Pragma("unroll") for (int i = 0; i < MI; ++i) _Pragma("unroll") for (int j = 0; j < NJ; ++j) { \
      const int row = rb_ + i * 16;                                                            \
      const int col = cb_ + j * 16;                                                            \
      body                                                                                     \
    }                                                                                          \
  }

#define EPI_ROW(i, body)                                                                       \
  {                                                                                            \
    int tid_ = threadIdx.x; asm volatile("" : "+v"(tid_));                                    \
    const int lane_ = tid_ & 63, wave_ = tid_ >> 6;                                            \
    const int row = m0 + (MI == 4 ? (wave_ >> 1) * 64 : 0) + (lane_ & 15) + (i) * 16;          \
    const int cb_ = n0 + (MI == 4 ? (wave_ & 1) : wave_) * 16 * NJ + (lane_ >> 4) * 4;         \
    _Pragma("unroll") for (int j = 0; j < NJ; ++j) {                                           \
      const int col = cb_ + j * 16;                                                            \
      body                                                                                     \
    }                                                                                          \
  }

DI int queue_next(unsigned* ctr, char* smem) {
  int* sitem = (int*)(smem + SMEM_BYTES);
  if (threadIdx.x == 0) *sitem = (int)atomicAdd(ctr, 1u);
  __syncthreads();
  const int it = *sitem;
  __syncthreads();
  return it;
}

DI void transpose_item(const float* __restrict__ src, int ldS, int col0, int ncols, int k0, bf16_t* __restrict__ dst, int ldD, int row0, char* smem) {
  float* tile = (float*)smem;
  int tid = threadIdx.x; asm volatile("" : "+v"(tid));
  const int tx = tid & 63, ty = tid >> 6;
  float v[32];
#pragma unroll
  for (int i = 0; i < 32; ++i) v[i] = (tx < ncols) ? src[(size_t)(k0 + ty + 4 * i) * ldS + col0 + tx] : 0.f;
#pragma unroll
  for (int i = 0; i < 32; ++i) tile[(ty + 4 * i) * 65 + tx] = v[i];
  __syncthreads();
  const int n = tid >> 2, ksg = (tid & 3) * 32;
  unsigned w[16];
#pragma unroll
  for (int i = 0; i < 16; ++i) w[i] = pk2(tile[(ksg + 2 * i) * 65 + n], tile[(ksg + 2 * i + 1) * 65 + n]);
  uint4* d = (uint4*)(dst + (size_t)(row0 + n) * ldD + k0 + ksg);
  d[0] = make_uint4(w[0], w[1], w[2], w[3]); d[1] = make_uint4(w[4], w[5], w[6], w[7]);
  d[2] = make_uint4(w[8], w[9], w[10], w[11]); d[3] = make_uint4(w[12], w[13], w[14], w[15]);
  __syncthreads();
}
DI void adaln_item(const Params& p, int it, char* smem) {
  const int cgp = it % 48, rg = it / 48, tid = threadIdx.x, lane = tid & 63, wv = tid >> 6;
  float* sc = (float*)smem;
#pragma unroll 1
  for (int kk = 0; kk < 4; ++kk) {
    const int k = tid + 256 * kk;
    float cv[16];
#pragma unroll
    for (int i = 0; i < 16; ++i) {
      const int sq = rg * 16 + i, sc_ = sq < NSEQ ? sq : NSEQ - 1;
      const float* rowp = sc_ < 8 ? p.cP + (size_t)sc_ * 1024 : p.cS + (size_t)(sc_ - 8) * 1024;
      cv[i] = rowp[k];
    }
#pragma unroll
    for (int i = 0; i < 16; ++i) sc[k * 16 + i] = (rg * 16 + i < NSEQ) ? siluf_(cv[i]) : 0.f;
  }
  __syncthreads();
  const int n = cgp * 64 + lane;
  float a[16];
#pragma unroll
  for (int i = 0; i < 16; ++i) a[i] = 0.f;
  const float* wp = p.wAda + (size_t)(wv * 256) * 3072 + n;
  const float* scp = sc + wv * 256 * 16;
#pragma unroll 1
  for (int k0 = 0; k0 < 256; k0 += 32) {
    float w[32];
#pragma unroll
    for (int u = 0; u < 32; ++u) w[u] = wp[(size_t)(k0 + u) * 3072];
#pragma unroll
    for (int u = 0; u < 32; ++u) {
#pragma unroll
      for (int q = 0; q < 4; ++q) {
        const float4 c = *(const float4*)(scp + (k0 + u) * 16 + 4 * q);
        a[4 * q] += w[u] * c.x; a[4 * q + 1] += w[u] * c.y; a[4 * q + 2] += w[u] * c.z; a[4 * q + 3] += w[u] * c.w;
      }
    }
  }
  __syncthreads();
  float* red = sc;
#pragma unroll
  for (int i = 0; i < 16; ++i) red[(wv * 16 + i) * 64 + lane] = a[i];
  __syncthreads();
  for (int o = tid; o < 1024; o += 256) {
    const int i = o >> 6, l = o & 63, nn = cgp * 64 + l, srow = rg * 16 + i;
    const float v = red[(0 * 16 + i) * 64 + l] + red[(1 * 16 + i) * 64 + l] + red[(2 * 16 + i) * 64 + l] + red[(3 * 16 + i) * 64 + l];
    if (srow < NSEQ) p.mod[(size_t)srow * 3072 + nn] = v + p.bAda[nn];
  }
  __syncthreads();
}
DI void phase0(const Params& p, char* smem) {
  const int NA = 432, NIT = NA + 1456;
  while (true) {
    const int it0 = queue_next(p.ctr + 2, smem);
    if (it0 >= NIT) break;
    if (it0 < NA) { adaln_item(p, it0, smem); continue; }
    const int it = it0 - NA;
    if (it < 1024) {
      const int grp = it >> 7, rem = it & 127, nt = rem >> 3, kt = rem & 7;
      const int srcb[8] = {0, 2048, 3072, 4096, 1024, 5120, 6160, 7184};
      const int dstb[8] = {0, 1024, 2048, 3072, ROW_ZA, ROW_ZB, ROW_GA, ROW_GB};
      int sb = 0, db = 0;
#pragma unroll
      for (int g = 0; g < 8; ++g) if (g == grp) { sb = srcb[g]; db = dstb[g]; }
      transpose_item(p.wIn, 8208, sb + nt * 64, 64, kt * 128, p.WinT, 1024, db + nt * 64, smem);
    } else if (it < 1040) {
      const int i2 = it - 1024, nt = i2 >> 3, kt = i2 & 7;
      transpose_item(p.wIn, 8208, 6144 + nt * 64, nt == 0 ? 16 : 0, kt * 128, p.WinT, 1024, 4096 + nt * 64, smem);
    } else if (it < 1072) {
      const int i3 = it - 1040, g = i3 >> 3, rem = i3 & 7, nt = rem >> 1, kt = rem & 1;
      transpose_item(p.poolW + g * 65536, 256, nt * 64, 64, kt * 128, p.PwT + g * 65536, 256, nt * 64, smem);
    } else {
      const int i4 = it - 1072, which = i4 >> 7, rem = i4 & 127, nt = rem >> 3, kt = rem & 7;
      const float* src = which == 0 ? p.pA : (which == 1 ? p.pB : p.wOut);
      bf16_t* dst = which == 0 ? p.PaT : (which == 1 ? p.PbT : p.WoT);
      transpose_item(src, 1024, nt * 64, 64, kt * 128, dst, 1024, nt * 64, smem);
    }
  }
}
DI void phase0b(const Params& p) {
  const int nvec = TT * 128;
  const int step = gridDim.x * 1024;
  int v0 = blockIdx.x * 1024 + threadIdx.x;
  f32x4 xa[4], xb[4];
  if (v0 < nvec) {
#pragma unroll
    for (int u = 0; u < 4; ++u) {
      const int v = v0 + u * 256, t = v >> 7, c = (v & 127) * 8;
      const float* xr = t < TP ? p.xP + (size_t)t * 1024 + c : p.xS + (size_t)(t - TP) * 1024 + c;
      xa[u] = *(const f32x4*)xr; xb[u] = *(const f32x4*)(xr + 4);
    }
  }
  for (; v0 < nvec; v0 += step) {
    f32x4 x0[4], x1[4], sh0[4], sh1[4], sc0[4], sc1[4];
#pragma unroll
    for (int u = 0; u < 4; ++u) {
      const int v = v0 + u * 256, t = v >> 7, c = (v & 127) * 8;
      const float* m = p.mod + (size_t)seq_of(t) * 3072 + c;
      x0[u] = xa[u]; x1[u] = xb[u];
      sh0[u] = *(const f32x4*)m; sh1[u] = *(const f32x4*)(m + 4);
      sc0[u] = *(const f32x4*)(m + 1024); sc1[u] = *(const f32x4*)(m + 1028);
    }
    if (v0 + step < nvec) {
#pragma unroll
      for (int u = 0; u < 4; ++u) {
        const int v = v0 + step + u * 256, t = v >> 7, c = (v & 127) * 8;
        const float* xr = t < TP ? p.xP + (size_t)t * 1024 + c : p.xS + (size_t)(t - TP) * 1024 + c;
        xa[u] = *(const f32x4*)xr; xb[u] = *(const f32x4*)(xr + 4);
      }
    }
#pragma unroll
    for (int u = 0; u < 4; ++u) {
      const int v = v0 + u * 256, t = v >> 7, c = (v & 127) * 8;
      uint4 o;
      o.x = pk2(x0[u][0] * (1.f + sc0[u][0]) + sh0[u][0], x0[u][1] * (1.f + sc0[u][1]) + sh0[u][1]);
      o.y = pk2(x0[u][2] * (1.f + sc0[u][2]) + sh0[u][2], x0[u][3] * (1.f + sc0[u][3]) + sh0[u][3]);
      o.z = pk2(x1[u][0] * (1.f + sc1[u][0]) + sh1[u][0], x1[u][1] * (1.f + sc1[u][1]) + sh1[u][1]);
      o.w = pk2(x1[u][2] * (1.f + sc1[u][2]) + sh1[u][2], x1[u][3] * (1.f + sc1[u][3]) + sh1[u][3]);
      *(uint4*)(p.hbuf + (size_t)t * 1024 + c) = o;
    }
  }
}
template <int MI, int NJ> DI void p1_tile(const Params& p, int m0, int n0, char* smem) {
  f32x4 acc[MI][NJ]; zero_acc(acc);
  gemm_acc<MI, NJ>(acc, p.hbuf + (size_t)m0 * 1024, 1024, p.WinT + (size_t)n0 * 1024, 1024, 1024, smem);
  EPI_LOOP(
    const f32x4 v = acc[i][j];
    if (col < 4096) { uint2 o; o.x = pk2(v[0], v[1]); o.y = pk2(v[2], v[3]); *(uint2*)(p.S0 + (size_t)row * 4096 + col) = o; }
    else if (col < 4112) { *(f32x4*)(p.praw + (size_t)row * 16 + (col - 4096)) = v; }
  )
}
DI void phase1(const Params& p, char* smem) {
  const int NW = NMT * 16, NIT = NW + NMT;
  for (int it = blockIdx.x; it < NIT; it += gridDim.x) {
    if (it < NW) p1_tile<4, 8>(p, (it >> 4) * 128, (it & 15) * 256, smem);
    else p1_tile<4, 4>(p, (it - NW) * 128, 4096, smem);
  }
}
template <int W> DI void pool_compute(const float (&r)[23][4], bool prompt, int p0, float (&po)[8][4]) {
#pragma unroll
  for (int i = 0; i < 8; ++i) {
    const float cnt = prompt ? (float)min(p0 + i + 1, W) : (float)W;
    const float inv = 1.f / cnt;
#pragma unroll
    for (int c = 0; c < 4; ++c) {
      float s = 0.f;
#pragma unroll
      for (int j = 0; j < W; ++j) s += r[15 + i - j][c];
      po[i][c] = s * inv - r[15 + i][c];
    }
  }
}
template <bool PROMPT> DI void p2_item(const Params& p, int gi) {
  const int tid = threadIdx.x, wave = tid >> 6, ch = tid * 4;
  constexpr bool prompt = PROMPT;
  int b = 0, p0 = 0, t0, sb = 0;
  if (prompt) { b = gi >> 8; p0 = (gi & 255) * 8; t0 = b * 2048 + p0; } else { sb = gi - 2048; t0 = TP + sb * 8; }
  const bf16_t* proj = p.S0;
  const bool wstate = (!prompt) || (p0 == 2040);
  const int gi_ = (tid & 63) >> 3, gh_ = tid & 7;
  const float braw_ = p.praw[(size_t)(t0 + gi_) * 16 + gh_], araw_ = p.praw[(size_t)(t0 + gi_) * 16 + 8 + gh_];
  const float dtb_ = p.dtBias[gh_], alg_ = p.aLog[gh_];
  {
    float r[23][4];
    {
      uint2 raw[23]; float4 rawf[15];
#pragma unroll
      for (int jj = 0; jj < 23; ++jj) {
        const int j = jj - 15;
        if (prompt) { const int jc = max(j, -p0); raw[jj] = *(const uint2*)(proj + (size_t)(t0 + jc) * 4096 + ch); }
        else if (j >= 0) raw[jj] = *(const uint2*)(proj + (size_t)(t0 + j) * 4096 + ch);
        else rawf[jj] = *(const float4*)(p.stPool + ((size_t)sb * 15 + jj) * 1024 + ch);
      }
#pragma unroll
      for (int jj = 0; jj < 23; ++jj) {
        const int j = jj - 15;
        if (prompt || j >= 0) {
          const float m = (!prompt || p0 + j >= 0) ? 1.f : 0.f;
          r[jj][0] = bflo(raw[jj].x) * m; r[jj][1] = bfhi(raw[jj].x) * m; r[jj][2] = bflo(raw[jj].y) * m; r[jj][3] = bfhi(raw[jj].y) * m;
        } else { r[jj][0] = rawf[jj].x; r[jj][1] = rawf[jj].y; r[jj][2] = rawf[jj].z; r[jj][3] = rawf[jj].w; }
      }
    }
    float po[8][4];
    if (wave == 0) pool_compute<2>(r, prompt, p0, po);
    else if (wave == 1) pool_compute<4>(r, prompt, p0, po);
    else if (wave == 2) pool_compute<8>(r, prompt, p0, po);
    else pool_compute<16>(r, prompt, p0, po);
#pragma unroll
    for (int i = 0; i < 8; ++i) { uint2 o; o.x = pk2(po[i][0], po[i][1]); o.y = pk2(po[i][2], po[i][3]); *(uint2*)(p.DS + (size_t)(t0 + i) * 1024 + ch) = o; }
    if (wstate) {
      float* dst = prompt ? p.out + OFF_POOLP + (size_t)b * 15 * 1024 : p.out + OFF_POOLS + (size_t)sb * 15 * 1024;
#pragma unroll
      for (int jj = 0; jj < 15; ++jj) *(float4*)(dst + jj * 1024 + ch) = make_float4(r[8 + jj][0], r[8 + jj][1], r[8 + jj][2], r[8 + jj][3]);
    }
  }
#pragma unroll
  for (int X = 0; X < 3; ++X) {
    const int cc = X * 1024 + ch;
    float v[11][4];
    {
      uint2 raw[11]; float4 rawf[3];
#pragma unroll
      for (int jj = 0; jj < 11; ++jj) {
        const int j = jj - 3;
        if (prompt) { const int jc = max(j, -p0); raw[jj] = *(const uint2*)(proj + (size_t)(t0 + jc) * 4096 + 1024 + cc); }
        else if (j >= 0) raw[jj] = *(const uint2*)(proj + (size_t)(t0 + j) * 4096 + 1024 + cc);
        else rawf[jj] = *(const float4*)(p.stConv + ((size_t)sb * 3 + jj) * 3072 + cc);
      }
#pragma unroll
      for (int jj = 0; jj < 11; ++jj) {
        const int j = jj - 3;
        if (prompt || j >= 0) {
          const float m = (!prompt || p0 + j >= 0) ? 1.f : 0.f;
          v[jj][0] = bflo(raw[jj].x) * m; v[jj][1] = bfhi(raw[jj].x) * m; v[jj][2] = bflo(raw[jj].y) * m; v[jj][3] = bfhi(raw[jj].y) * m;
        } else { v[jj][0] = rawf[jj].x; v[jj][1] = rawf[jj].y; v[jj][2] = rawf[jj].z; v[jj][3] = rawf[jj].w; }
      }
    }
    if (wstate) {
      float* dst = prompt ? p.out + OFF_CONVP + (size_t)b * 3 * 3072 : p.out + OFF_CONVS + (size_t)sb * 3 * 3072;
#pragma unroll
      for (int jj = 0; jj < 3; ++jj) *(float4*)(dst + jj * 3072 + cc) = make_float4(v[8 + jj][0], v[8 + jj][1], v[8 + jj][2], v[8 + jj][3]);
    }
    float cw[4][4];
#pragma unroll
    for (int m = 0; m < 4; ++m) { const float4 w = *(const float4*)(p.convW + m * 3072 + cc); cw[m][0] = w.x; cw[m][1] = w.y; cw[m][2] = w.z; cw[m][3] = w.w; }
    float o[8][4];
#pragma unroll
    for (int i = 0; i < 8; ++i) {
#pragma unroll
      for (int c = 0; c < 4; ++c) {
        const float s = cw[0][c] * v[i][c] + cw[1][c] * v[i + 1][c] + cw[2][c] * v[i + 2][c] + cw[3][c] * v[i + 3][c];
        o[i][c] = siluf_(s);
      }
      if (X < 2) {
        float ss = o[i][0] * o[i][0] + o[i][1] * o[i][1] + o[i][2] * o[i][2] + o[i][3] * o[i][3];
        ss += __shfl_xor(ss, 1); ss += __shfl_xor(ss, 2); ss += __shfl_xor(ss, 4); ss += __shfl_xor(ss, 8); ss += __shfl_xor(ss, 16);
        const float rn = rsqrtf(ss + 1e-6f) * (X == 0 ? 0.08838834764831845f : 1.f);
#pragma unroll
        for (int c = 0; c < 4; ++c) o[i][c] *= rn;
      }
    }
    if (X == 0) {
      if (prompt) {
        const int hd = tid >> 5, d = (tid & 31) * 4, ks = d >> 5, dd = d & 31, t_ = dd >> 4, kq = (dd & 15) >> 2;
        const int CH = ((b * 32 + (p0 >> 6)) * 8 + hd);
#pragma unroll
        for (int i2 = 0; i2 < 4; ++i2) {
          const int ia = 2 * i2, ib = 2 * i2 + 1;
          unsigned mx = pk2(o[t_ ? ia : ib][0], o[t_ ? ia : ib][1]), my = pk2(o[t_ ? ia : ib][2], o[t_ ? ia : ib][3]);
          const unsigned ox = (unsigned)__shfl_xor((int)mx, 4), oy = (unsigned)__shfl_xor((int)my, 4);
          const int i = t_ ? ib : ia;
          const unsigned kx = pk2(o[i][0], o[i][1]), ky = pk2(o[i][2], o[i][3]);
          uint4 w;
          if (t_ == 0) { w.x = kx; w.y = ky; w.z = ox; w.w = oy; } else { w.x = ox; w.y = oy; w.z = kx; w.w = ky; }
          const int c = (p0 & 63) + i, mt = c >> 4, r_ = c & 15;
          *(uint4*)(p.Y0 + (size_t)CH * 8192 + ((mt * 4 + ks) * 64 + kq * 16 + r_) * 8) = w;
        }
      } else {
#pragma unroll
        for (int i = 0; i < 8; ++i) { uint2 w; w.x = pk2(o[i][0], o[i][1]); w.y = pk2(o[i][2], o[i][3]); *(uint2*)(p.Y0 + (size_t)(t0 + i) * 1024 + ch) = w; }
      }
    } else if (X == 1) {
#pragma unroll
      for (int i = 0; i < 8; ++i) {
        uint2 w; w.x = pk2(o[i][0], o[i][1]); w.y = pk2(o[i][2], o[i][3]);
        bf16_t* kd = prompt ? p.Y1 + (size_t)(t0 + i) * 1024 + ch : p.KS + (size_t)(t0 - TP + i) * 1024 + ch;
        *(uint2*)kd = w;
      }
    } else {
#pragma unroll
      for (int g2 = 0; g2 < 2; ++g2) {
        uint4 w0, w1;
        w0.x = pk2(o[4 * g2][0], o[4 * g2 + 1][0]); w0.y = pk2(o[4 * g2 + 2][0], o[4 * g2 + 3][0]);
        w0.z = pk2(o[4 * g2][1], o[4 * g2 + 1][1]); w0.w = pk2(o[4 * g2 + 2][1], o[4 * g2 + 3][1]);
        w1.x = pk2(o[4 * g2][2], o[4 * g2 + 1][2]); w1.y = pk2(o[4 * g2 + 2][2], o[4 * g2 + 3][2]);
        w1.z = pk2(o[4 * g2][3], o[4 * g2 + 1][3]); w1.w = pk2(o[4 * g2 + 2][3], o[4 * g2 + 3][3]);
        uint4* dst = (uint4*)(p.VB + ((size_t)((t0 >> 2) + g2) * 1024 + ch) * 4);
        dst[0] = w0; dst[1] = w1;
      }
    }
  }
  if (tid < 64) {
    const int i = tid >> 3, hd = tid & 7;
    const float xx = araw_ + dtb_;
    const float sp = xx > 20.f ? xx : log1pf(__expf(xx));
    p.betaA[(size_t)(t0 + i) * 8 + hd] = sigmoidf_(braw_);
    p.gA[(size_t)(t0 + i) * 8 + hd] = -__expf(alg_) * sp;
  }
}
DI void phase2(const Params& p) {
  for (int it = blockIdx.x; it < 2176; it += gridDim.x) { const int gi = (it & 7) * 272 + (it >> 3); if (gi < 2048) p2_item<true>(p, gi); else p2_item<false>(p, gi); }
}
template <int MI, int NJ> DI void p3a_tile(const Params& p, int m0, int n0, char* smem) {
  f32x4 acc[MI][NJ]; zero_acc(acc);
  gemm_acc<MI, NJ>(acc, p.hbuf + (size_t)m0 * 1024, 1024, p.WinT + (size_t)(ROW_ZA + n0) * 1024, 1024, 1024, smem);
  EPI_LOOP(
    const f32x4 ps = *(const f32x4*)(p.poolScale + col);
    const f32x4 v = acc[i][j];
    uint2 o; o.x = pk2(siluf_(v[0]) * ps[0], siluf_(v[1]) * ps[1]); o.y = pk2(siluf_(v[2]) * ps[2], siluf_(v[3]) * ps[3]);
    *(uint2*)(p.S0 + (size_t)row * 1024 + col) = o;
  )
  zero_acc(acc);
  const int grp = n0 >> 8;
  gemm_acc<MI, NJ>(acc, p.DS + (size_t)m0 * 1024 + grp * 256, 1024, p.PwT + (size_t)grp * 65536 + (size_t)(n0 & 255) * 256, 256, 256, smem);
#pragma unroll
  for (int i = 0; i < MI; ++i) {
    uint2 stv[NJ];
    EPI_ROW(i, stv[j] = *(const uint2*)(p.S0 + (size_t)row * 1024 + col); )
    EPI_ROW(i,
      const f32x4 v = acc[i][j];
      const uint2 st = stv[j];
      uint2 o; o.x = pk2(v[0] * bflo(st.x), v[1] * bfhi(st.x)); o.y = pk2(v[2] * bflo(st.y), v[3] * bfhi(st.y));
      *(uint2*)(p.S0 + (size_t)row * 1024 + col) = o;
    )
  }
}
template <bool DRY> DI void p3b_item(const Params& p, int CH, char* smem) {
  int tid = threadIdx.x; asm volatile("" : "+v"(tid));
  const int lane = tid & 63, w = tid >> 6, r = lane & 15, kq = lane >> 4;
  const int hd = CH & 7, cn = CH >> 3, t0 = cn * 64;
  float* gcs = (float*)smem; float* bts = gcs + 64; float* Lm = bts + 64; char* ksm = (char*)(Lm + 4096);
  u32x4 kraw[4], qraw4[4];
  uint2 vraw[16];
  bf16_t* const vbase = p.VB + ((size_t)(t0 >> 2) * 1024 + hd * 128 + (tid & 127)) * 4;
#pragma unroll
  for (int i = 0; i < 4; ++i) {
    const int id = tid + 256 * i, row = id >> 4, c16 = id & 15;
    kraw[i] = *(const u32x4*)(p.Y1 + (size_t)(t0 + row) * 1024 + hd * 128 + c16 * 8);
  }
#pragma unroll
  for (int ks = 0; ks < 4; ++ks) qraw4[ks] = *(const u32x4*)(p.Y0 + (size_t)CH * 8192 + ((w * 4 + ks) * 64 + lane) * 8);
  const int tgb = t0 + (tid & 63);
  const float g_in = p.gA[(size_t)tgb * 8 + hd], b_in = p.betaA[(size_t)tgb * 8 + hd];
  if (tid < 128) {
#pragma unroll
    for (int i = 0; i < 16; ++i) vraw[i] = *(const uint2*)(vbase + (size_t)i * 4096);
  }
#pragma unroll
  for (int i = 0; i < 4; ++i) {
    const int id = tid + 256 * i, row = id >> 4, c16 = id & 15;
    *(u32x4*)(ksm + row * 272 + c16 * 16) = kraw[i];
  }
  if (tid < 64) {
    float g = g_in;
#pragma unroll
    for (int off = 1; off < 64; off <<= 1) { const float v = __shfl_up(g, off); if (lane >= off) g += v; }
    gcs[tid] = g; bts[tid] = b_in;
  }
  __syncthreads();
  const float gl = gcs[63];
  {
    f32x4 akk[4], aqk[4];
#pragma unroll
    for (int nt = 0; nt < 4; ++nt) { akk[nt] = (f32x4){0.f, 0.f, 0.f, 0.f}; aqk[nt] = (f32x4){0.f, 0.f, 0.f, 0.f}; }
    const float gam = __expf(gcs[16 * w + r]);
#pragma unroll
    for (int ks = 0; ks < 4; ++ks) {
      const bf16x8 ka = *(const bf16x8*)(ksm + (16 * w + r) * 272 + ks * 64 + kq * 16);
      bf16_t* qptr = p.Y0 + (size_t)CH * 8192 + ((w * 4 + ks) * 64 + lane) * 8;
      const uint4 qraw = make_uint4(qraw4[ks][0], qraw4[ks][1], qraw4[ks][2], qraw4[ks][3]);
      const bf16x8 qa = __builtin_bit_cast(bf16x8, qraw4[ks]);
#pragma unroll
      for (int nt = 0; nt < 4; ++nt) {
        const bf16x8 kb = *(const bf16x8*)(ksm + (16 * nt + r) * 272 + ks * 64 + kq * 16);
        const s16x4 lo = *(const s16x4*)(ksm + (16 * nt + r) * 272 + (32 * ks + 4 * kq) * 2);
        const s16x4 hi = *(const s16x4*)(ksm + (16 * nt + r) * 272 + (32 * ks + 16 + 4 * kq) * 2);
        const bf16x8 kbp = __builtin_shufflevector(lo, hi, 0, 1, 2, 3, 4, 5, 6, 7);
        akk[nt] = MFMA16(ka, kb, akk[nt]);
        aqk[nt] = MFMA16(qa, kbp, aqk[nt]);
      }
      uint4 qo;
      qo.x = pk2(bflo(qraw.x) * gam, bfhi(qraw.x) * gam); qo.y = pk2(bflo(qraw.y) * gam, bfhi(qraw.y) * gam);
      qo.z = pk2(bflo(qraw.z) * gam, bfhi(qraw.z) * gam); qo.w = pk2(bflo(qraw.w) * gam, bfhi(qraw.w) * gam);
      if (!DRY) *(uint4*)qptr = qo;
    }
#pragma unroll
    for (int nt = 0; nt < 4; ++nt)
#pragma unroll
      for (int j = 0; j < 4; ++j) {
        const int rr = 16 * w + 4 * kq + j, cc = 16 * nt + r;
        const float dec = __expf(fminf(gcs[rr] - gcs[cc], 0.f));
        Lm[rr * 64 + cc] = (cc < rr) ? bts[rr] * dec * akk[nt][j] : 0.f;
        const float qv = (cc <= rr) ? dec * aqk[nt][j] : 0.f;
        const int r3 = rr & 15, ks3 = cc >> 5, dd = cc & 31, t3 = dd >> 4, kq3 = (dd & 15) >> 2, j3 = dd & 3;
        p.S3[(size_t)CH * 4096 + ((w * 2 + ks3) * 64 + kq3 * 16 + r3) * 8 + 4 * t3 + j3] = f2bf(qv);
      }
  }
  __syncthreads();
  {
    float x[64];
    if (tid < 128) {
#pragma unroll
      for (int i = 0; i < 16; ++i) {
        const uint2 u = vraw[i];
        x[4 * i] = bts[4 * i] * bflo(u.x); x[4 * i + 1] = bts[4 * i + 1] * bfhi(u.x);
        x[4 * i + 2] = bts[4 * i + 2] * bflo(u.y); x[4 * i + 3] = bts[4 * i + 3] * bfhi(u.y);
      }
    } else {
      const int d = tid - 128;
#pragma unroll
      for (int rr = 0; rr < 64; ++rr) x[rr] = bts[rr] * __expf(gcs[rr]) * bf2f(*(const bf16_t*)(ksm + rr * 272 + d * 2));
    }
    {
      f32x4 la[12], lb[12], lt[4];
      la[0] = *(const f32x4*)(Lm + 64);
#pragma unroll
      for (int rr = 1; rr < 64; ++rr) {
        if (rr + 1 < 64) {
#pragma unroll
          for (int j4 = 0; j4 < (rr + 4) / 4 && j4 < 12; ++j4) {
            if (rr & 1) lb[j4] = *(const f32x4*)(Lm + (rr + 1) * 64 + 4 * j4); else la[j4] = *(const f32x4*)(Lm + (rr + 1) * 64 + 4 * j4);
          }
        }
#pragma unroll
        for (int j4 = 12; j4 < (rr + 3) / 4; ++j4) lt[j4 - 12] = *(const f32x4*)(Lm + rr * 64 + 4 * j4);
        __builtin_amdgcn_sched_barrier(0);
        float s0 = x[rr], s1 = 0.f;
#pragma unroll
        for (int j4 = 0; j4 < (rr + 3) / 4; ++j4) {
          const f32x4 l = j4 >= 12 ? lt[j4 - 12] : ((rr & 1) ? la[j4] : lb[j4]);
          s0 -= l[0] * x[4 * j4]; s1 -= l[1] * x[4 * j4 + 1]; s0 -= l[2] * x[4 * j4 + 2]; s1 -= l[3] * x[4 * j4 + 3];
        }
        x[rr] = s0 + s1;
        __builtin_amdgcn_sched_barrier(0);
      }
    }
    if (tid < 128) {
#pragma unroll
      for (int i = 0; i < 16; ++i) { uint2 u; u.x = pk2(x[4 * i], x[4 * i + 1]); u.y = pk2(x[4 * i + 2], x[4 * i + 3]); if (!DRY) *(uint2*)(vbase + (size_t)i * 4096) = u; }
    } else {
      const int d = tid - 128, ks_ = d >> 5, dd = d & 31, t_ = dd >> 4, kq_ = (dd & 15) >> 2, j_ = dd & 3;
      bf16_t* wk = p.S1 + (size_t)CH * 8192 + (ks_ * 64 + kq_ * 16) * 8 + 4 * t_ + j_;
#pragma unroll
      for (int rr = 0; rr < 64; ++rr) wk[((rr >> 4) * 4 * 64 + (rr & 15)) * 8] = f2bf(-x[rr]);
    }
  }
#pragma unroll
  for (int i = 0; i < 4; ++i) {
    const int slot = tid + 256 * i, f = slot >> 6, ln = slot & 63, mtp = f >> 1, ksp = f & 1, r2 = ln & 15, kq2 = ln >> 4;
    float vv[8];
#pragma unroll
    for (int t_ = 0; t_ < 2; ++t_)
#pragma unroll
      for (int j = 0; j < 4; ++j) {
        const int c = 32 * ksp + 16 * t_ + 4 * kq2 + j;
        vv[4 * t_ + j] = bf2f(*(const bf16_t*)(ksm + c * 272 + (16 * mtp + r2) * 2)) * __expf(gl - gcs[c]);
      }
    uint4 o; o.x = pk2(vv[0], vv[1]); o.y = pk2(vv[2], vv[3]); o.z = pk2(vv[4], vv[5]); o.w = pk2(vv[6], vv[7]);
    *(uint4*)(p.S2 + (size_t)CH * 8192 + (size_t)slot * 8) = o;
  }
  if (tid == 0) p.glastA[CH] = __expf(gl);
  __syncthreads();
}
template <bool DRY> DI void phase3(const Params& p, char* smem) {
#pragma unroll 1
  for (int pass = 0; pass < 2; ++pass) {
    const bool items = (pass == 0) == (blockIdx.x < 256);
    if (items) {
      while (true) {
        const int it = queue_next(p.ctr + 4, smem);
        if (it >= 2048) break;
        p3b_item<DRY>(p, it, smem);
      }
    } else {
      while (true) {
        const int it = queue_next(p.ctr + 5, smem);
        if (it >= NT1K) break;
        int m0, n0;
        if (tile_1k(it, m0, n0)) p3a_tile<4, 8>(p, m0, n0, smem); else p3a_tile<2, 2>(p, m0, n0, smem);
      }
    }
  }
}
DI bf16x8 pack8(const f32x4& a, const f32x4& b) {
  uint4 u; u.x = pk2(a[0], a[1]); u.y = pk2(a[2], a[3]); u.z = pk2(b[0], b[1]); u.w = pk2(b[2], b[3]);
  return __builtin_bit_cast(bf16x8, u);
}
struct ScanPre { u32x4 wk[4], qg[4], kt[4], qd[2]; uint2 wv[4]; float gl; };
DI void scan_prefetch(const Params& p, ScanPre& r, int chunk  , int hd, int tid, int rq, int ecol) {
  const size_t CH = (size_t)(chunk * 8 + hd);
#pragma unroll
  for (int i = 0; i < 4; ++i) {
    r.wk[i] = ((const u32x4*)(p.S1 + CH * 8192))[tid + 256 * i];
    r.qg[i] = ((const u32x4*)(p.Y0 + CH * 8192))[tid + 256 * i];
    r.kt[i] = ((const u32x4*)(p.S2 + CH * 8192))[tid + 256 * i];
  }
#pragma unroll
  for (int i = 0; i < 2; ++i) r.qd[i] = ((const u32x4*)(p.S3 + CH * 4096))[tid + 256 * i];
  const bf16_t* vb = p.VB + ((size_t)(chunk * 16 + rq) * 1024 + hd * 128 + ecol) * 4;
#pragma unroll
  for (int mt = 0; mt < 4; ++mt) r.wv[mt] = *(const uint2*)(vb + (size_t)(4 * mt) * 4096);
  r.gl = p.glastA[CH];
}
template <bool DRY> DI void scan_step(const Params& p, ScanPre& r, f32x4 (&S)[8], int chunk, bool more, int hd, int tid, int lane, int rq, int ecol, char* smem) {
  __syncthreads();
#pragma unroll
  for (int i = 0; i < 4; ++i) {
    ((u32x4*)smem)[tid + 256 * i] = r.wk[i];
    ((u32x4*)(smem + 16384))[tid + 256 * i] = r.qg[i];
    ((u32x4*)(smem + 32768))[tid + 256 * i] = r.kt[i];
  }
#pragma unroll
  for (int i = 0; i < 2; ++i) ((u32x4*)(smem + 49152))[tid + 256 * i] = r.qd[i];
  f32x4 u[4];
#pragma unroll
  for (int mt = 0; mt < 4; ++mt) u[mt] = (f32x4){bflo(r.wv[mt].x), bfhi(r.wv[mt].x), bflo(r.wv[mt].y), bfhi(r.wv[mt].y)};
  const float gl = r.gl;
  __syncthreads();
  if (more) scan_prefetch(p, r, chunk + 2, hd, tid, rq, ecol);
  bf16x8 Sb[4];
#pragma unroll
  for (int ks = 0; ks < 4; ++ks) Sb[ks] = pack8(S[2 * ks], S[2 * ks + 1]);
  f32x4 o[4];
#pragma unroll
  for (int mt = 0; mt < 4; ++mt) {
    o[mt] = (f32x4){0.f, 0.f, 0.f, 0.f};
#pragma unroll
    for (int ks = 0; ks < 4; ++ks) {
      const bf16x8 a = *(const bf16x8*)(smem + ((mt * 4 + ks) * 64 + lane) * 16);
      u[mt] = MFMA16(a, Sb[ks], u[mt]);
      const bf16x8 q = *(const bf16x8*)(smem + 16384 + ((mt * 4 + ks) * 64 + lane) * 16);
      o[mt] = MFMA16(q, Sb[ks], o[mt]);
    }
  }
  bf16x8 ub[2];
#pragma unroll
  for (int ks = 0; ks < 2; ++ks) ub[ks] = pack8(u[2 * ks], u[2 * ks + 1]);
#pragma unroll
  for (int mt = 0; mt < 4; ++mt)
#pragma unroll
    for (int ks = 0; ks < 2; ++ks) {
      const bf16x8 a = *(const bf16x8*)(smem + 49152 + ((mt * 2 + ks) * 64 + lane) * 16);
      o[mt] = MFMA16(a, ub[ks], o[mt]);
    }
#pragma unroll
  for (int mt = 0; mt < 8; ++mt) {
    S[mt] = S[mt] * gl;
#pragma unroll
    for (int ks = 0; ks < 2; ++ks) {
      const bf16x8 a = *(const bf16x8*)(smem + 32768 + ((mt * 2 + ks) * 64 + lane) * 16);
      S[mt] = MFMA16(a, ub[ks], S[mt]);
    }
  }
  bf16_t* vb = p.VB + ((size_t)(chunk * 16 + rq) * 1024 + hd * 128 + ecol) * 4;
#pragma unroll
  for (int mt = 0; mt < 4; ++mt) { uint2 v; v.x = pk2(o[mt][0], o[mt][1]); v.y = pk2(o[mt][2], o[mt][3]); if (!DRY) *(uint2*)(vb + (size_t)(4 * mt) * 4096) = v; }
}
template <bool DRY> DI void scan_unit(const Params& p, int unit, char* smem) {
  const int tid = threadIdx.x, lane = tid & 63, w = tid >> 6, col = lane & 15, rq = lane >> 4;
  const int bh = unit >> 1, b = bh >> 3, hd = bh & 7, e0 = ((unit & 1) * 4 + w) * 16, ecol = e0 + col;
  f32x4 S[8];
#pragma unroll
  for (int i = 0; i < 8; ++i) S[i] = (f32x4){0.f, 0.f, 0.f, 0.f};
  ScanPre ra, rb;
  scan_prefetch(p, ra, b * 32, hd, tid, rq, ecol);
  scan_prefetch(p, rb, b * 32 + 1, hd, tid, rq, ecol);
#pragma unroll 1
  for (int n = 0; n < 32; n += 2) {
    scan_step<DRY>(p, ra, S, b * 32 + n, n + 2 < 32, hd, tid, lane, rq, ecol, smem);
    scan_step<DRY>(p, rb, S, b * 32 + n + 1, n + 3 < 32, hd, tid, lane, rq, ecol, smem);
  }
  float* dp = p.out + OFF_DELTAP + ((size_t)bh * 128) * 128 + e0 + col;
#pragma unroll
  for (int mt = 0; mt < 8; ++mt)
#pragma unroll
    for (int j = 0; j < 4; ++j) dp[(size_t)(16 * mt + 4 * rq + j) * 128] = S[mt][j];
  __syncthreads();
}
template <bool DRY> DI void sample_item(const Params& p, int item, char* smem) {
  const int tid = threadIdx.x, e = tid >> 1, dh = tid & 1;
  const int sb = item >> 3, hd = item & 7, tb = TP + sb * 8;
  float* qs = (float*)smem; float* ksm = qs + 1024; float* av = ksm + 1024; float* bv = av + 8;
#pragma unroll
  for (int i = 0; i < 4; ++i) {
    const int id = tid + 256 * i, tk = id >> 7, d = id & 127;
    qs[id] = bf2f(p.Y0[(size_t)(tb + tk) * 1024 + hd * 128 + d]);
    ksm[id] = bf2f(p.KS[(size_t)(tb - TP + tk) * 1024 + hd * 128 + d]);
  }
  if (tid < 8) { av[tid] = __expf(p.gA[(size_t)(tb + tid) * 8 + hd]); bv[tid] = p.betaA[(size_t)(tb + tid) * 8 + hd]; }
  float S[64];
  const float* sp = p.stDelta + ((size_t)(sb * 8 + hd) * 128 + dh * 64) * 128 + e;
#pragma unroll
  for (int d0 = 0; d0 < 64; d0 += 4) {
    S[d0] = __builtin_nontemporal_load(sp); S[d0 + 1] = __builtin_nontemporal_load(sp + 128); S[d0 + 2] = __builtin_nontemporal_load(sp + 256); S[d0 + 3] = __builtin_nontemporal_load(sp + 384);
    sp += 512; asm volatile("" : "+v"(sp));
  }
  __syncthreads();
#pragma unroll 1
  for (int i = 0; i < 8; ++i) {
    const int t = tb + i;
    bf16_t* vp = p.VB + ((size_t)(t >> 2) * 1024 + hd * 128 + e) * 4 + (t & 3);
    const float v = bf2f(*vp), a = av[i], be = bv[i];
    const float* kr = ksm + i * 128 + dh * 64; const float* qr = qs + i * 128 + dh * 64;
    float kS = 0.f;
#pragma unroll
    for (int d4 = 0; d4 < 16; ++d4) {
      const float4 kk = *(const float4*)(kr + 4 * d4);
      kS += S[4 * d4] * kk.x; kS += S[4 * d4 + 1] * kk.y; kS += S[4 * d4 + 2] * kk.z; kS += S[4 * d4 + 3] * kk.w;
      if ((d4 & 3) == 3) __builtin_amdgcn_sched_barrier(0);
    }
    kS += __shfl_xor(kS, 1);
    const float uu = be * (v - a * kS);
    float oo = 0.f;
#pragma unroll
    for (int d4 = 0; d4 < 16; ++d4) {
      const float4 kk = *(const float4*)(kr + 4 * d4);
      const float4 qq = *(const float4*)(qr + 4 * d4);
      S[4 * d4] = a * S[4 * d4] + kk.x * uu; oo += S[4 * d4] * qq.x;
      S[4 * d4 + 1] = a * S[4 * d4 + 1] + kk.y * uu; oo += S[4 * d4 + 1] * qq.y;
      S[4 * d4 + 2] = a * S[4 * d4 + 2] + kk.z * uu; oo += S[4 * d4 + 2] * qq.z;
      S[4 * d4 + 3] = a * S[4 * d4 + 3] + kk.w * uu; oo += S[4 * d4 + 3] * qq.w;
      if ((d4 & 1) == 1) __builtin_amdgcn_sched_barrier(0);
    }
    oo += __shfl_xor(oo, 1);
    if (dh == 0 && !DRY) *vp = f2bf(oo);
  }
  float* dp = p.out + OFF_DELTAS + ((size_t)(sb * 8 + hd) * 128 + dh * 64) * 128 + e;
#pragma unroll
  for (int d0 = 0; d0 < 64; d0 += 4) {
    __builtin_nontemporal_store(S[d0], dp); __builtin_nontemporal_store(S[d0 + 1], dp + 128); __builtin_nontemporal_store(S[d0 + 2], dp + 256); __builtin_nontemporal_store(S[d0 + 3], dp + 384);
    dp += 512; asm volatile("" : "+v"(dp));
  }
  __syncthreads();
}
template <int MI, int NJ> DI void p4a_tile(const Params& p, int m0, int n0, char* smem) {
  f32x4 acc[MI][NJ]; zero_acc(acc);
  gemm_acc<MI, NJ>(acc, p.hbuf + (size_t)m0 * 1024, 1024, p.WinT + (size_t)(ROW_GA + n0) * 1024, 1024, 1024, smem);
  EPI_LOOP(
    const f32x4 v = acc[i][j];
    uint2 o; o.x = pk2(sigmoidf_(v[0]), sigmoidf_(v[1])); o.y = pk2(sigmoidf_(v[2]), sigmoidf_(v[3]));
    *(uint2*)(p.Y1 + (size_t)row * 1024 + col) = o;
  )
  zero_acc(acc);
  gemm_acc<MI, NJ>(acc, p.S0 + (size_t)m0 * 1024, 1024, p.PaT + (size_t)n0 * 1024, 1024, 1024, smem);
#pragma unroll
  for (int i = 0; i < MI; ++i) {
    uint2 stv[NJ];
    EPI_ROW(i, stv[j] = *(const uint2*)(p.Y1 + (size_t)row * 1024 + col); )
    EPI_ROW(i,
      const f32x4 v = acc[i][j];
      const uint2 st = stv[j];
      uint2 o; o.x = pk2(v[0] * bflo(st.x), v[1] * bfhi(st.x)); o.y = pk2(v[2] * bflo(st.y), v[3] * bfhi(st.y));
      *(uint2*)(p.Y1 + (size_t)row * 1024 + col) = o;
    )
  }
}
template <bool DRY> DI void phase4(const Params& p, char* smem) {
  if (blockIdx.x < 128) scan_unit<DRY>(p, blockIdx.x, smem);
#pragma unroll 1
  for (int pass = 0; pass < 2; ++pass) {
    const bool samples = (pass == 0) == (blockIdx.x < 256);
    if (samples) {
      while (true) {
        const int it = queue_next(p.ctr + (DRY ? 1 : 0), smem);
        if (it >= 1024) break;
        sample_item<DRY>(p, it, smem);
      }
    } else {
      while (true) {
        const int it = queue_next(p.ctr + 32 + (DRY ? 1 : 0), smem);
        if (it >= NT1K) break;
        int m0, n0;
        if (tile_1k(it, m0, n0)) p4a_tile<4, 8>(p, m0, n0, smem); else p4a_tile<2, 2>(p, m0, n0, smem);
      }
    }
  }
}
template <int MI, int NJ> DI void p5_tile(const Params& p, int m0, int n0, char* smem) {
  constexpr int BM = MI == 4 ? 128 : 32;
  f32x4 acc[MI][NJ]; zero_acc(acc);
  gemm_acc<MI, NJ>(acc, p.hbuf + (size_t)m0 * 1024, 1024, p.WinT + (size_t)(ROW_ZB + n0) * 1024, 1024, 1024, smem);
  float* rs = (float*)smem;
  constexpr int NH = NJ == 8 ? 2 : 1;
#pragma unroll
  for (int h2 = 0; h2 < NH; ++h2) {
    const int row = threadIdx.x >> 1, hf = threadIdx.x & 1, t = m0 + (row < BM ? row : 0);
    const bf16_t* op = p.VB + ((size_t)(t >> 2) * 1024 + n0 + h2 * 128 + hf * 64) * 4 + (t & 3);
    bf16_t ovr[64];
#pragma unroll
    for (int e = 0; e < 64; ++e) ovr[e] = op[e * 4];
    float ss = 0.f;
#pragma unroll
    for (int e = 0; e < 64; ++e) { const float v = bf2f(ovr[e]); ss += v * v; }
    ss += __shfl_xor(ss, 1);
    if (hf == 0 && row < BM) rs[h2 * BM + row] = rsqrtf(ss * (1.f / 128.f) + 1e-6f);
  }
  __syncthreads();
#pragma unroll
  for (int i = 0; i < MI; ++i) {
    bf16_t ov[NJ][4];
    EPI_ROW(i,
      const bf16_t* op = p.VB + ((size_t)(row >> 2) * 1024 + col) * 4 + (row & 3);
      _Pragma("unroll") for (int c = 0; c < 4; ++c) ov[j][c] = op[c * 4];
    )
    EPI_ROW(i,
      const f32x4 v = acc[i][j];
      const float rr = rs[((col - n0) >> 7) * BM + row - m0];
      const f32x4 hw = *(const f32x4*)(p.hnw + (col & 127));
      float y[4];
      _Pragma("unroll") for (int c = 0; c < 4; ++c) y[c] = bf2f(ov[j][c]) * rr * hw[c] * siluf_(v[c]);
      uint2 o; o.x = pk2(y[0], y[1]); o.y = pk2(y[2], y[3]);
      *(uint2*)(p.S0 + (size_t)row * 1024 + col) = o;
    )
  }
  __syncthreads();
}
DI void phase5(const Params& p, char* smem) {
  for (int it = blockIdx.x; it < NT1K; it += gridDim.x) {
    int m0, n0;
    if (tile_1k(it, m0, n0)) p5_tile<4, 8>(p, m0, n0, smem); else p5_tile<2, 2>(p, m0, n0, smem);
  }
}
template <int MI, int NJ> DI void p6_tile(const Params& p, int m0, int n0, char* smem) {
  f32x4 acc[MI][NJ]; zero_acc(acc);
    gemm_acc<MI, NJ>(acc, p.hbuf + (size_t)m0 * 1024, 1024, p.WinT + (size_t)(ROW_GB + n0) * 1024, 1024, 1024, smem);
    EPI_LOOP(
      const f32x4 v = acc[i][j];
      uint2 o; o.x = pk2(sigmoidf_(v[0]), sigmoidf_(v[1])); o.y = pk2(sigmoidf_(v[2]), sigmoidf_(v[3]));
      *(uint2*)(p.S1 + (size_t)row * 1024 + col) = o;
    )
    zero_acc(acc);
    gemm_acc<MI, NJ>(acc, p.S0 + (size_t)m0 * 1024, 1024, p.PbT + (size_t)n0 * 1024, 1024, 1024, smem);
#pragma unroll
  for (int i = 0; i < MI; ++i) {
    uint2 stv[NJ], mav[NJ];
    EPI_ROW(i, stv[j] = *(const uint2*)(p.S1 + (size_t)row * 1024 + col); mav[j] = *(const uint2*)(p.Y1 + (size_t)row * 1024 + col); )
    EPI_ROW(i,
      const f32x4 v = acc[i][j];
      const uint2 st = stv[j];
      const uint2 ma = mav[j];
      uint2 o;
      o.x = pk2(bflo(ma.x) + v[0] * bflo(st.x), bfhi(ma.x) + v[1] * bfhi(st.x));
      o.y = pk2(bflo(ma.y) + v[2] * bflo(st.y), bfhi(ma.y) + v[3] * bfhi(st.y));
      *(uint2*)(p.S1 + (size_t)row * 1024 + col) = o;
    )
  }
}
DI void phase6(const Params& p, char* smem) {
  for (int it = blockIdx.x; it < NT1K; it += gridDim.x) {
    int m0, n0;
    if (tile_1k(it, m0, n0)) p6_tile<4, 8>(p, m0, n0, smem); else p6_tile<2, 2>(p, m0, n0, smem);
  }
}
template <int MI, int NJ> DI void p7_tile(const Params& p, int m0, int n0, char* smem) {
  const float alpha = 1.189207115002721f;
  f32x4 acc[MI][NJ]; zero_acc(acc);
    gemm_acc<MI, NJ>(acc, p.S1 + (size_t)m0 * 1024, 1024, p.WoT + (size_t)n0 * 1024, 1024, 1024, smem);
#pragma unroll
  for (int i = 0; i < MI; ++i) {
    f32x4 gtv[NJ], xvv[NJ];
    EPI_ROW(i,
      gtv[j] = *(const f32x4*)(p.mod + (size_t)seq_of(row) * 3072 + 2048 + col);
      const float* xr = row < TP ? p.xP + (size_t)row * 1024 + col : p.xS + (size_t)(row - TP) * 1024 + col;
      xvv[j] = *(const f32x4*)xr;
    )
    EPI_ROW(i,
      const f32x4 v = acc[i][j];
      const f32x4 gt = gtv[j];
      const f32x4 xv = xvv[j];
      f32x4 rv;
      _Pragma("unroll") for (int c = 0; c < 4; ++c) rv[c] = alpha * xv[c] + (1.f + gt[c]) * v[c];
      *(f32x4*)(p.out + (size_t)row * 1024 + col) = rv;
    )
  }
}
DI void phase7(const Params& p, char* smem) {
  for (int it = blockIdx.x; it < NT1K; it += gridDim.x) {
    int m0, n0;
    if (tile_1k(it, m0, n0)) p7_tile<4, 8>(p, m0, n0, smem); else p7_tile<2, 2>(p, m0, n0, smem);
  }
}
DI void phase8(const Params& p) {
  int tid8 = threadIdx.x; asm volatile("" : "+v"(tid8));
  const int lane = tid8 & 63, wv = tid8 >> 6;
  const int stride = gridDim.x * 4;
  int row = blockIdx.x * 4 + wv;
  f32x4 v[4], n1[4], n2[4];
  if (row < TT) {
#pragma unroll
    for (int i = 0; i < 4; ++i) n1[i] = *(const f32x4*)(p.out + (size_t)row * 1024 + i * 256 + lane * 4);
  }
  if (row + stride < TT) {
#pragma unroll
    for (int i = 0; i < 4; ++i) n2[i] = *(const f32x4*)(p.out + (size_t)(row + stride) * 1024 + i * 256 + lane * 4);
  }
  f32x4 g[4], bb[4];
#pragma unroll
  for (int i = 0; i < 4; ++i) { g[i] = *(const f32x4*)(p.lnG + i * 256 + lane * 4); bb[i] = *(const f32x4*)(p.lnB + i * 256 + lane * 4); }
  for (; row < TT; row += stride) {
    float* rp = p.out + (size_t)row * 1024;
#pragma unroll
    for (int i = 0; i < 4; ++i) { v[i] = n1[i]; n1[i] = n2[i]; }
    if (row + 2 * stride < TT) {
#pragma unroll
      for (int i = 0; i < 4; ++i) n2[i] = *(const f32x4*)(rp + (size_t)(2 * stride) * 1024 + i * 256 + lane * 4);
    }
    float s = 0.f;
#pragma unroll
    for (int i = 0; i < 4; ++i) s += v[i][0] + v[i][1] + v[i][2] + v[i][3];
#pragma unroll
    for (int off = 1; off < 64; off <<= 1) s += __shfl_xor(s, off);
    const float mu = s * (1.f / 1024.f);
    float q = 0.f;
#pragma unroll
    for (int i = 0; i < 4; ++i)
#pragma unroll
      for (int c = 0; c < 4; ++c) { const float d = v[i][c] - mu; q += d * d; }
#pragma unroll
    for (int off = 1; off < 64; off <<= 1) q += __shfl_xor(q, off);
    const float rstd = rsqrtf(q * (1.f / 1024.f) + 1e-5f);
#pragma unroll
    for (int i = 0; i < 4; ++i) {
      f32x4 o;
#pragma unroll
      for (int c = 0; c < 4; ++c) o[c] = (v[i][c] - mu) * rstd * g[i][c] + bb[i][c];
      __builtin_nontemporal_store(o, (f32x4*)(rp + i * 256 + lane * 4));
    }
  }
}

DI void run_phase(const Params& p, int ph, char* smem) {
  switch (ph) {
    case 0: phase0(p, smem); break;
    case 1: phase0b(p); break;
    case 2: phase1(p, smem); break;
    case 3: phase2(p); break;
    case 4: phase3<false>(p, smem); break;
    case 5: phase4<false>(p, smem); break;
    case 6: phase5(p, smem); break;
    case 7: phase6(p, smem); break;
    case 8: phase7(p, smem); break;
    default: phase8(p); break;
  }
}
constexpr int NPHASE = 10;

#ifndef DUP
#define DUP -1
#endif
__global__ void __launch_bounds__(256, 2) fwd_mega(Params p) {
  __shared__ __attribute__((aligned(16))) char smem[SMEM_BYTES + 16];
  __shared__ uint4 xb_words;
  if (threadIdx.x == 0) xb_words = make_uint4(0u, 0u, 0u, 0u);
  __syncthreads();
  XcdBarrier xb = xcd_barrier_post(p.bar, (volatile LAS unsigned*)&xb_words);
  if (p.bar == nullptr) cg::this_grid().sync();
  phase0(p, smem); xcd_barrier(xb);
  if (DUP == 0) { phase0(p, smem); xcd_barrier(xb); }
  phase0b(p); xcd_barrier(xb);
  if (DUP == 1) { phase0b(p); xcd_barrier(xb); }
  phase1(p, smem); xcd_barrier(xb);
  if (DUP == 2) { phase1(p, smem); xcd_barrier(xb); }
  phase2(p); xcd_barrier(xb);
  if (DUP == 3) { phase2(p); xcd_barrier(xb); }
  if (DUP == 9) { for (int i = 0; i < 10; ++i) xcd_barrier(xb); }
  if (DUP == 4) { phase3<true>(p, smem); xcd_barrier(xb); }
  phase3<false>(p, smem); xcd_barrier(xb);
  if (DUP == 5) { phase4<true>(p, smem); xcd_barrier(xb); }
  phase4<false>(p, smem); xcd_barrier(xb);
  phase5(p, smem); xcd_barrier(xb);
  if (DUP == 6) { phase5(p, smem); xcd_barrier(xb); }
  phase6(p, smem); xcd_barrier(xb);
  if (DUP == 7) { phase6(p, smem); xcd_barrier(xb); }
  phase7(p, smem); xcd_barrier(xb);
  if (DUP == 8) { phase7(p, smem); xcd_barrier(xb); }
  phase8(p);
}
__global__ void __launch_bounds__(256, 2) fwd_phase(Params p, int ph) {
  __shared__ __attribute__((aligned(16))) char smem[SMEM_BYTES + 16];
  run_phase(p, ph, smem);
}

extern "C" void kernel_launch(void* const* d_in, const int* in_sizes, int n_in, void* d_out, int out_size, void* d_ws, size_t ws_size, hipStream_t stream) {
  Params p{};
  p.xP = (const float*)d_in[0]; p.xS = (const float*)d_in[1]; p.stPool = (const float*)d_in[2]; p.stConv = (const float*)d_in[3];
  p.stDelta = (const float*)d_in[4]; p.cP = (const float*)d_in[5]; p.cS = (const float*)d_in[6]; p.wAda = (const float*)d_in[7];
  p.bAda = (const float*)d_in[8]; p.wIn = (const float*)d_in[9]; p.convW = (const float*)d_in[10]; p.aLog = (const float*)d_in[11];
  p.dtBias = (const float*)d_in[12]; p.hnw = (const float*)d_in[13]; p.poolW = (const float*)d_in[14]; p.poolScale = (const float*)d_in[15];
  p.pA = (const float*)d_in[16]; p.pB = (const float*)d_in[17]; p.wOut = (const float*)d_in[18]; p.lnG = (const float*)d_in[19]; p.lnB = (const float*)d_in[20];
  p.out = (float*)d_out;
  char* w = (char*)d_ws; size_t off = 0;
  auto take = [&](size_t bytes) { char* r = w + off; off += (bytes + 255) & ~(size_t)255; return r; };
  p.WinT = (bf16_t*)take((size_t)WIN_ROWS * 1024 * 2);
  p.PwT = (bf16_t*)take(4 * 65536 * 2);
  p.PaT = (bf16_t*)take(1024 * 1024 * 2); p.PbT = (bf16_t*)take(1024 * 1024 * 2); p.WoT = (bf16_t*)take(1024 * 1024 * 2);
  p.mod = (float*)take((size_t)NSEQ * 3072 * 4);
  p.ctr = (unsigned*)take(256);
  p.bar = (unsigned*)take(XCD_BAR_WORDS * 4);
  p.praw = (float*)take((size_t)TT * 16 * 4);
  p.betaA = (float*)take((size_t)TT * 8 * 4); p.gA = (float*)take((size_t)TT * 8 * 4);
  p.glastA = (float*)take(16384 * 4);
  p.hbuf = (bf16_t*)take(GSZ * 2);
  p.S0 = (bf16_t*)take(GSZ * 2); p.S1 = (bf16_t*)take(GSZ * 2); p.S2 = (bf16_t*)take(GSZ * 2); p.S3 = (bf16_t*)take(GSZ * 2);
  p.VB = (bf16_t*)take(GSZ * 2);
  p.KS = (bf16_t*)take((size_t)TS * 1024 * 2);
  p.Y0 = (bf16_t*)d_out; p.Y1 = p.Y0 + GSZ;
  p.DS = (bf16_t*)((float*)d_out + OFF_DELTAS);
  if (off > ws_size) { fprintf(stderr, "workspace too small: need %zu have %zu\n", off, ws_size); return; }
  (void)hipMemsetAsync(p.ctr, 0, 256 + XCD_BAR_WORDS * 4, stream);
#if MEGA
  static int grid_blocks = 0;
  if (!grid_blocks) {
    int dev = 0, cus = 0, per_cu = 0;
    hipGetDevice(&dev);
    hipDeviceGetAttribute(&cus, hipDeviceAttributeMultiprocessorCount, dev);
    hipOccupancyMaxActiveBlocksPerMultiprocessor(&per_cu, fwd_mega, 256, 0);
    if (per_cu > 2) per_cu = 2;
    grid_blocks = cus * per_cu;
    grid_blocks &= ~7;
  }
  void* args[] = {&p};
  hipError_t e = hipLaunchCooperativeKernel((void*)fwd_mega, dim3(grid_blocks), dim3(256), args, 0, stream);
  if (e != hipSuccess) fprintf(stderr, "cooperative launch failed: %s (grid %d)\n", hipGetErrorString(e), grid_blocks);
#else
  for (int ph = 0; ph < NPHASE; ++ph) fwd_phase<<<512, 256, 0, stream>>>(p, ph);
#endif
}
```
